# Optimizing an MI355X kernel written in HIP

```python
import math
import jax, jax.numpy as jnp
from jax import lax
import numpy as np

D_MODEL = 1024
BATCH = 8
SEQ = 2048
DEPTH = 2

N_MIXERS = 2
N_A = (DEPTH + 1) // 2
N_B = DEPTH // 2
N_SUB = 3
D_FF = 2816
FFN_RES = 0.5
EPS = 1e-6

MLA_HEADS = 16
Q_LORA = 384
KV_LORA = 256
QK_NOPE = 64
QK_ROPE = 32
V_HEAD = 64
ROPE_THETA = 10000.0
Q_BLOCK = 128

DIL_GROUPS = ((128, 1), (512, 4), (2048, 16))
N_GROUPS = 3
DIL_HEADS = 16
DIL_HEAD_DIM = 64
DIL_BLOCK = 128
DIL_WIDTH = DIL_HEADS * DIL_HEAD_DIM

N_BUCKETS = 32
MAX_DISTANCE = 2048

kernel_name = "hybrid_mla_dilated_macaron"


def rmsnorm(x, g):
    xf = x.astype(jnp.float32)
    y = xf * lax.rsqrt(jnp.mean(xf * xf, axis=-1, keepdims=True) + EPS)
    return (y * g.astype(jnp.float32)).astype(x.dtype)


def swiglu(h, w_gate, w_up, w_down):
    return (jax.nn.silu(h @ w_gate) * (h @ w_up)) @ w_down


def rope(x, pos):
    half = x.shape[-1] // 2
    freqs = ROPE_THETA ** (-jnp.arange(half, dtype=jnp.float32) / half)
    ang = pos[:, None] * freqs[None, :]
    cos = jnp.cos(ang)[None, :, None, :]
    sin = jnp.sin(ang)[None, :, None, :]
    x1 = x[..., :half].astype(jnp.float32)
    x2 = x[..., half:].astype(jnp.float32)
    return jnp.concatenate([x1 * cos - x2 * sin, x1 * sin + x2 * cos], axis=-1).astype(x.dtype)


def causal_block_attention(q, k, v, scale):
    B, S, H, dq = q.shape
    nb = S // Q_BLOCK
    qb = q.reshape(B, nb, Q_BLOCK, H, dq).transpose(1, 0, 3, 2, 4)
    kt = k.transpose(0, 2, 1, 3)
    vt = v.transpose(0, 2, 1, 3)
    kpos = jnp.arange(S)

    def one_block(args):
        qi, n = args
        s = jnp.einsum('bhqd,bhkd->bhqk', qi, kt).astype(jnp.float32) * scale
        qpos = n * Q_BLOCK + jnp.arange(Q_BLOCK)
        s = jnp.where(kpos[None, :] <= qpos[:, None], s, -jnp.inf)
        p = jax.nn.softmax(s, axis=-1).astype(vt.dtype)
        return jnp.einsum('bhqk,bhkd->bhqd', p, vt)

    out = lax.map(one_block, (qb, jnp.arange(nb)))
    return out.transpose(1, 0, 3, 2, 4).reshape(B, S, H, v.shape[-1])


def mla(h, w_in, q_norm, w_q_up, kv_norm, w_kv_up, w_o):
    B, S, _ = h.shape
    lat = h @ w_in
    cq = lat[..., :Q_LORA]
    ckv = lat[..., Q_LORA:Q_LORA + KV_LORA]
    k_rope = lat[..., Q_LORA + KV_LORA:][:, :, None, :]
    q = (rmsnorm(cq, q_norm) @ w_q_up).reshape(B, S, MLA_HEADS, QK_NOPE + QK_ROPE)
    kv = (rmsnorm(ckv, kv_norm) @ w_kv_up).reshape(B, S, MLA_HEADS, QK_NOPE + V_HEAD)
    pos = jnp.arange(S, dtype=jnp.float32)
    q = jnp.concatenate([q[..., :QK_NOPE], rope(q[..., QK_NOPE:], pos)], axis=-1)
    k_rope = jnp.broadcast_to(rope(k_rope, pos), (B, S, MLA_HEADS, QK_ROPE))
    k = jnp.concatenate([kv[..., :QK_NOPE], k_rope.astype(kv.dtype)], axis=-1)
    v = kv[..., QK_NOPE:]
    o = causal_block_attention(q, k, v, (QK_NOPE + QK_ROPE) ** -0.5)
    return o.reshape(B, S, MLA_HEADS * V_HEAD) @ w_o


def t5_bucket(dist):
    max_exact = N_BUCKETS // 2
    d = jnp.maximum(dist, 1).astype(jnp.float32)
    large = max_exact + (jnp.log(d / max_exact) / math.log(MAX_DISTANCE / max_exact)
                         * (N_BUCKETS - max_exact)).astype(jnp.int32)
    large = jnp.minimum(large, N_BUCKETS - 1)
    return jnp.where(dist < max_exact, dist, large)


def strided_window_attention(q, k, v, dilation, span, bias_table):
    B, S, H, E = q.shape
    L = S // dilation
    nb = -(-L // DIL_BLOCK)
    Lp = nb * DIL_BLOCK
    qs = q.reshape(B, L, dilation, H, E)
    qb = jnp.pad(qs, ((0, 0), (0, Lp - L), (0, 0), (0, 0), (0, 0))).reshape(B, nb, DIL_BLOCK, dilation, H, E)

    def windows(t):
        tp = jnp.pad(t.reshape(B, L, dilation, H, E),
                     ((0, 0), (DIL_BLOCK, Lp - L), (0, 0), (0, 0), (0, 0)))
        tp = tp.reshape(B, nb + 1, DIL_BLOCK, dilation, H, E)
        return jnp.concatenate([tp[:, :-1], tp[:, 1:]], axis=2)

    kw, vw = windows(k), windows(v)
    s = jnp.einsum('bnqrhe,bnkrhe->bnrhqk', qb, kw).astype(jnp.float32) * (E ** -0.5)
    iq = jnp.arange(DIL_BLOCK)[:, None]
    ik = jnp.arange(2 * DIL_BLOCK)[None, :]
    rel = DIL_BLOCK + iq - ik
    in_window = (rel >= 0) & (rel <= span)
    bucket = t5_bucket(jnp.maximum(rel, 0) * dilation)
    bias = jnp.transpose(bias_table[bucket], (2, 0, 1)).astype(jnp.float32)
    key_m = (jnp.arange(nb)[:, None] - 1) * DIL_BLOCK + jnp.arange(2 * DIL_BLOCK)[None, :]
    valid = in_window[None] & (key_m >= 0)[:, None, :]
    logits = jnp.where(valid[None, :, None, None], s + bias, -jnp.inf)
    lse = jax.nn.logsumexp(logits, axis=-1)
    p = jnp.exp(logits - lse[..., None]).astype(v.dtype)
    o = jnp.einsum('bnrhqk,bnkrhe->bnqrhe', p, vw)
    o = o.reshape(B, Lp, dilation, H, E)[:, :L].reshape(B, S, H, E)
    lse = jnp.transpose(lse, (0, 1, 4, 2, 3)).reshape(B, Lp, dilation, H)[:, :L].reshape(B, S, H)
    return o, lse


def dilated_attention(h, w_in, w_o, rel_bias):
    B, S, _ = h.shape
    proj = (h @ w_in).reshape(B, S, N_GROUPS, 3, DIL_HEADS, DIL_HEAD_DIM)
    outs, lses = [], []
    for g, (window, dilation) in enumerate(DIL_GROUPS):
        o, lse = strided_window_attention(
            proj[:, :, g, 0], proj[:, :, g, 1], proj[:, :, g, 2],
            dilation, window // dilation, rel_bias[:, g * DIL_HEADS:(g + 1) * DIL_HEADS])
        outs.append(o)
        lses.append(lse)
    alpha = jax.nn.softmax(jnp.stack(lses, axis=0), axis=0)
    o = jnp.sum(alpha[..., None] * jnp.stack(outs, axis=0).astype(jnp.float32), axis=0)
    return o.astype(h.dtype).reshape(B, S, DIL_WIDTH) @ w_o


def sandwich(x, fn, pre_g, post_g, shift, scale, gate, res_w):
    hn = rmsnorm(x, pre_g) * (1 + scale[:, None, :]) + shift[:, None, :]
    y = rmsnorm(fn(hn), post_g)
    return x + res_w * gate[:, None, :] * y


def setup_inputs(seed: int = 0) -> dict:
    key = jax.random.key(seed)
    ks = jax.random.split(key, 20)
    D = D_MODEL
    nrm = lambda k, shape, fan: jax.random.normal(k, shape, jnp.float32) * fan ** -0.5
    return {
        "x": jax.random.normal(ks[0], (BATCH, SEQ, D), jnp.float32),
        "c": jax.random.normal(ks[1], (BATCH, D), jnp.float32),
        "norm_pre": 1.0 + 0.05 * jax.random.normal(ks[2], (DEPTH, N_SUB, D), jnp.float32),
        "norm_post": 1.0 + 0.05 * jax.random.normal(ks[3], (DEPTH, N_SUB, D), jnp.float32),
        "w_mod": nrm(ks[4], (DEPTH, D, N_SUB * 3 * D), D) * 0.5,
        "b_mod": 0.02 * jax.random.normal(ks[5], (DEPTH, N_SUB * 3 * D), jnp.float32),
        "ffn_w_gate": nrm(ks[6], (DEPTH, 2, D, D_FF), D),
        "ffn_w_up": nrm(ks[7], (DEPTH, 2, D, D_FF), D),
        "ffn_w_down": nrm(ks[8], (DEPTH, 2, D_FF, D), D_FF),
        "mla_w_in": nrm(ks[9], (N_A, D, Q_LORA + KV_LORA + QK_ROPE), D),
        "mla_q_norm": 1.0 + 0.05 * jax.random.normal(ks[10], (N_A, Q_LORA), jnp.float32),
        "mla_w_q_up": nrm(ks[11], (N_A, Q_LORA, MLA_HEADS * (QK_NOPE + QK_ROPE)), Q_LORA),
        "mla_kv_norm": 1.0 + 0.05 * jax.random.normal(ks[12], (N_A, KV_LORA), jnp.float32),
        "mla_w_kv_up": nrm(ks[13], (N_A, KV_LORA, MLA_HEADS * (QK_NOPE + V_HEAD)), KV_LORA),
        "mla_w_o": nrm(ks[14], (N_A, MLA_HEADS * V_HEAD, D), MLA_HEADS * V_HEAD),
        "dil_w_in": nrm(ks[15], (N_B, D, N_GROUPS * 3 * DIL_WIDTH), D),
        "dil_w_o": nrm(ks[16], (N_B, DIL_WIDTH, D), DIL_WIDTH),
        "rel_bias": 0.5 * jax.random.normal(ks[17], (N_BUCKETS, N_GROUPS * DIL_HEADS), jnp.float32),
    }


def reference(x, c, norm_pre, norm_post, w_mod, b_mod, ffn_w_gate, ffn_w_up, ffn_w_down,
              mla_w_in, mla_q_norm, mla_w_q_up, mla_kv_norm, mla_w_kv_up, mla_w_o,
              dil_w_in, dil_w_o, rel_bias):
    B = x.shape[0]
    for i in range(DEPTH):
        mod = (jax.nn.silu(c) @ w_mod[i] + b_mod[i]).reshape(B, N_SUB, 3, D_MODEL)

        def ffn_first(h, i=i):
            return swiglu(h, ffn_w_gate[i, 0], ffn_w_up[i, 0], ffn_w_down[i, 0])

        def ffn_second(h, i=i):
            return swiglu(h, ffn_w_gate[i, 1], ffn_w_up[i, 1], ffn_w_down[i, 1])

        if i % N_MIXERS == 0:
            a = i // N_MIXERS
            def mixer(h, a=a):
                return mla(h, mla_w_in[a], mla_q_norm[a], mla_w_q_up[a],
                           mla_kv_norm[a], mla_w_kv_up[a], mla_w_o[a])
        else:
            b = i // N_MIXERS
            def mixer(h, b=b):
                return dilated_attention(h, dil_w_in[b], dil_w_o[b], rel_bias)

        x = sandwich(x, ffn_first, norm_pre[i, 0], norm_post[i, 0],
                     mod[:, 0, 0], mod[:, 0, 1], mod[:, 0, 2], FFN_RES)
        x = sandwich(x, mixer, norm_pre[i, 1], norm_post[i, 1],
                     mod[:, 1, 0], mod[:, 1, 1], mod[:, 1, 2], 1.0)
        x = sandwich(x, ffn_second, norm_pre[i, 2], norm_post[i, 2],
                     mod[:, 2, 0], mod[:, 2, 1], mod[:, 2, 2], FFN_RES)
    return x
```

```cpp
#include <hip/hip_runtime.h>
#include <hip/hip_cooperative_groups.h>
#include <cstdio>
#include <cstdint>
namespace cg = cooperative_groups;

#ifndef MK_ONE_LAUNCH
#define MK_ONE_LAUNCH 1
#endif

#define LAS __attribute__((address_space(3)))
typedef unsigned short bf16_t;
typedef short bf16x8 __attribute__((ext_vector_type(8)));
typedef short s16x4 __attribute__((ext_vector_type(4)));
typedef float f32x2 __attribute__((ext_vector_type(2)));
typedef float f32x4 __attribute__((ext_vector_type(4)));
typedef float f32x16 __attribute__((ext_vector_type(16)));
typedef unsigned u32x2 __attribute__((ext_vector_type(2)));
typedef unsigned u32x4 __attribute__((ext_vector_type(4)));

constexpr int M = 16384, D = 1024, SEQ = 2048, NBATCH = 8, FF = 2816;
constexpr float EPS = 1e-6f;
constexpr float LOG2E = 1.4426950408889634f;
constexpr float C2_MLA = 0.10206207261596575f * LOG2E;
constexpr float C2_DIL = 0.125f * LOG2E;

constexpr size_t MiB = 1u << 20;
constexpr size_t WS_CTL = 0;
constexpr size_t WS_WT = 1 * MiB;
constexpr size_t WS_MOD = 100 * MiB;
constexpr size_t WS_COS = 101 * MiB;
constexpr size_t WS_SIN = WS_COS + 131072;
constexpr size_t WS_BIAS = 101 * MiB + 512 * 1024;
constexpr size_t WS_HN = 102 * MiB;
constexpr size_t WS_ACT = 134 * MiB;
constexpr size_t WS_Y = 222 * MiB;
constexpr size_t WS_LAT = 134 * MiB;
constexpr size_t WS_Q = 134 * MiB;
constexpr size_t WS_CQN = 182 * MiB;
constexpr size_t WS_CKVN = 194 * MiB;
constexpr size_t WS_KN = 202 * MiB;
constexpr size_t WS_V = 234 * MiB;
constexpr size_t WS_KR = 266 * MiB;
constexpr size_t WS_PROJ = 134 * MiB;
constexpr size_t WS_SO = 230 * MiB;
constexpr size_t WS_SM = 294 * MiB;
constexpr size_t WS_SL = 295 * MiB;
constexpr size_t WS_END = 296 * MiB;

constexpr size_t W_FFN_SZ = (size_t)5632 * 1024 + (size_t)1024 * 2816;
constexpr size_t W_GU0 = 0, W_DN0 = (size_t)5632 * 1024;
constexpr size_t W_MLAIN = 4 * W_FFN_SZ;
constexpr size_t W_QUP = W_MLAIN + (size_t)768 * 1024;
constexpr size_t W_KVUP = W_QUP + (size_t)1536 * 384;
constexpr size_t W_MLAO = W_KVUP + (size_t)2048 * 256;
constexpr size_t W_DILIN = W_MLAO + (size_t)1024 * 1024;
constexpr size_t W_DILO = W_DILIN + (size_t)9216 * 1024;
constexpr size_t W_END = W_DILO + (size_t)1024 * 1024;
static_assert(WS_WT + W_END * 2 <= WS_MOD, "weight copies fit");

constexpr int LDS_BYTES = 147456;
constexpr int RING_BYTES = 131072;

__device__ __forceinline__ unsigned cvt_pk_bf16(float lo, float hi) { unsigned r; asm volatile("v_cvt_pk_bf16_f32 %0, %1, %2" : "=v"(r) : "v"(lo), "v"(hi)); return r; }
__device__ __forceinline__ float wave_sum(float v) {
#pragma unroll
    for (int o = 1; o < 64; o <<= 1) v += __shfl_xor(v, o);
    return v;
}
__device__ __forceinline__ float fast_silu(float g) { return g * __builtin_amdgcn_rcpf(1.0f + __builtin_amdgcn_exp2f(-g * LOG2E)); }

namespace pg8 {
constexpr int BM = 256, BK = 64, HALF = 128, HTB = HALF * BK * 2, STAGE_BYTES = 8 * HTB, NXCD = 8, WGM = 8;
__host__ __device__ __forceinline__ int lds_byte(int r, int c) { const int st = (r >> 4) * 2 + (c >> 5), rr = r & 15, cc = c & 31, ob = rr * 64 + cc * 2; return st * 1024 + (ob ^ (((ob >> 9) & 1) << 5)); }
__host__ __device__ __forceinline__ void stage_rc(int b, int& R, int& C) { const int st = b / 1024, sb = b % 1024, swz = sb ^ (((sb >> 9) & 1) << 5); R = (st >> 1) * 16 + swz / 64; C = (st & 1) * 32 + (swz % 64) / 2; }
__host__ __device__ __forceinline__ int perm32(int rho) { const int n = rho >> 4, i = rho & 15; return 8 * (i >> 2) + 4 * n + (i & 3); }

struct Unit { int pm, pn; };
struct Gemm { const bf16_t* A; const bf16_t* Bt; int M, N, K; };

struct StaticOrder {
    int nM, nN, nwg, G, c;
    __host__ __device__ void init(int M_, int N_, int G_, int c_) { nM = M_ / BM; nN = N_ / BM; nwg = nM * nN; G = G_; c = c_; }
    __host__ __device__ bool next(int i, Unit& u) const {
        const long L = (long)i * G + c; if (L >= nwg) return false;
        int wgid = (int)L; { const int q = nwg / NXCD, r = nwg % NXCD, xcd = wgid % NXCD, off = wgid / NXCD; wgid = (xcd < r ? xcd * (q + 1) : r * (q + 1) + (xcd - r) * q) + off; }
        const int nig = WGM * nN, gid = wgid / nig, fm = gid * WGM, gsz = (nM - fm) < WGM ? (nM - fm) : WGM;
        u.pm = fm + ((wgid % nig) % gsz); u.pn = (wgid % nig) / gsz; return true;
    }
    __device__ __forceinline__ void a_ready(const Unit&) const {}
    __device__ __forceinline__ void done(const Unit&) const {}
};

struct EpiF32 {
    static constexpr bool PERM = false, AFTER_DRAIN = false;
    float* C; int ldc;
    __device__ __forceinline__ void operator()(const f32x4 (&acc)[2][2][4][2], const Unit& u, int wr, int wc, int fr, int fq) const {
        const int row0 = u.pm * BM + wr * 64 + fr, col0 = u.pn * BM + wc * 32 + 4 * fq;
#pragma unroll
        for (int ai = 0; ai < 2; ++ai)
#pragma unroll
            for (int m = 0; m < 4; ++m) { float* rowp = C + (size_t)(row0 + ai * HALF + m * 16) * ldc + col0;
#pragma unroll
                for (int bj = 0; bj < 2; ++bj)
#pragma unroll
                    for (int n = 0; n < 2; ++n) *(f32x4*)(rowp + bj * HALF + n * 16) = acc[ai][bj][m][n]; }
    }
};
struct EpiBf16 {
    static constexpr bool PERM = true, AFTER_DRAIN = false;
    bf16_t* O; int ldc; int split_cols; size_t split_stride; float scale0;
    __device__ __forceinline__ void operator()(const f32x4 (&acc)[2][2][4][2], const Unit& u, int wr, int wc, int fr, int fq) const {
        const int row0 = u.pm * BM + wr * 64 + fr; int colt = u.pn * BM; bf16_t* base = O;
        float sc = 1.f; if (split_cols) { const int t = colt / split_cols; base += (size_t)t * split_stride; colt -= t * split_cols; if (t == 0) sc = scale0; }
        const int col0 = colt + wc * 32 + 8 * fq;
#pragma unroll
        for (int ai = 0; ai < 2; ++ai)
#pragma unroll
            for (int m = 0; m < 4; ++m) { bf16_t* rowp = base + (size_t)(row0 + ai * HALF + m * 16) * ldc + col0;
#pragma unroll
                for (int bj = 0; bj < 2; ++bj) { f32x4 v0 = acc[ai][bj][m][0] * sc, v1 = acc[ai][bj][m][1] * sc;
                    u32x4 w; w.x = cvt_pk_bf16(v0[0], v0[1]); w.y = cvt_pk_bf16(v0[2], v0[3]); w.z = cvt_pk_bf16(v1[0], v1[1]); w.w = cvt_pk_bf16(v1[2], v1[3]);
                    *(u32x4*)(rowp + bj * HALF) = w; } }
    }
};
struct EpiSwiGLU {
    static constexpr bool PERM = true, AFTER_DRAIN = false;
    bf16_t* O; int ldc;
    __device__ __forceinline__ void operator()(const f32x4 (&acc)[2][2][4][2], const Unit& u, int wr, int wc, int fr, int fq) const {
        const int row0 = u.pm * BM + wr * 64 + fr, col0 = u.pn * HALF + wc * 32 + 8 * fq;
#pragma unroll
        for (int ai = 0; ai < 2; ++ai)
#pragma unroll
            for (int m = 0; m < 4; ++m) { bf16_t* rowp = O + (size_t)(row0 + ai * HALF + m * 16) * ldc + col0;
                const f32x4 g0 = acc[ai][0][m][0], g1 = acc[ai][0][m][1], u0 = acc[ai][1][m][0], u1 = acc[ai][1][m][1];
                float v[8];
#pragma unroll
                for (int e = 0; e < 4; ++e) { v[e] = fast_silu(g0[e]) * u0[e]; v[4 + e] = fast_silu(g1[e]) * u1[e]; }
                u32x4 w; w.x = cvt_pk_bf16(v[0], v[1]); w.y = cvt_pk_bf16(v[2], v[3]); w.z = cvt_pk_bf16(v[4], v[5]); w.w = cvt_pk_bf16(v[6], v[7]);
                *(u32x4*)rowp = w; }
    }
};
struct EpiQ {
    static constexpr bool PERM = false, AFTER_DRAIN = false;
    bf16_t* O; const float* cosT; const float* sinT; float scale;
    __device__ __forceinline__ void operator()(const f32x4 (&acc)[2][2][4][2], const Unit& u, int wr, int wc, int fr, int fq) const {
        const int row0 = u.pm * BM + wr * 64 + fr;
        const int G0 = u.pn * 8 + wc, G1 = G0 + 4;
        const bool rope0 = (G0 % 3) == 2, rope1 = (G1 % 3) == 2;
#pragma unroll
        for (int ai = 0; ai < 2; ++ai)
#pragma unroll
            for (int m = 0; m < 4; ++m) {
                const int row = row0 + ai * HALF + m * 16;
                f32x4 c = (f32x4){1.f, 1.f, 1.f, 1.f}, s = (f32x4){0.f, 0.f, 0.f, 0.f};
                if (rope0 || rope1) { const int pos = row & (SEQ - 1); c = *(const f32x4*)(cosT + pos * 16 + 4 * fq); s = *(const f32x4*)(sinT + pos * 16 + 4 * fq); }
#pragma unroll
                for (int bj = 0; bj < 2; ++bj) {
                    const bool rope = bj ? rope1 : rope0;
                    f32x4 x1 = acc[ai][bj][m][0], x2 = acc[ai][bj][m][1];
                    if (rope) { const f32x4 o1 = x1 * c - x2 * s, o2 = x1 * s + x2 * c; x1 = o1; x2 = o2; }
                    x1 = x1 * scale; x2 = x2 * scale;
                    bf16_t* rowp = O + (size_t)row * 1536 + (bj ? G1 : G0) * 32 + 4 * fq;
                    u32x2 w1, w2; w1.x = cvt_pk_bf16(x1[0], x1[1]); w1.y = cvt_pk_bf16(x1[2], x1[3]); w2.x = cvt_pk_bf16(x2[0], x2[1]); w2.y = cvt_pk_bf16(x2[2], x2[3]);
                    *(u32x2*)rowp = w1; *(u32x2*)(rowp + 16) = w2; }
                asm volatile("" ::: "memory");
            }
    }
};

template <class Epi, class Sched, bool ALIGN_EPI = false, bool SP2 = false>
__device__ __forceinline__ void gemm_phase(int tid_in, LAS unsigned char* lds, const Gemm g, const Sched& S, const Epi& E) {
    const int tid = tid_in, wid = __builtin_amdgcn_readfirstlane(tid >> 6), lane = tid & 63, wr = wid >> 2, wc = wid & 3, fr = lane & 15, fq = lane >> 4;
    int K_ = g.K; asm volatile("" : "+s"(K_));
    const int K = K_, nt = K / BK;
    unsigned voffA[2], voffB[2];
#pragma unroll
    for (int i = 0; i < 2; ++i) { int R, C; stage_rc(tid * 16 + i * 8192, R, C); const int Rb = Epi::PERM ? ((R & ~31) + perm32(R & 31)) : R;
        voffA[i] = (unsigned)(R * K + C) * 2u; voffB[i] = (unsigned)(Rb * K + C) * 2u; }
    const size_t kstep = (size_t)(BK * 2);
    const size_t hstep = (size_t)HALF * K * 2;
    const size_t tstep = 2 * hstep;
    const unsigned ldsw = (unsigned)wid * 1024u;
    const int aoff = lds_byte(wr * 64 + fr, fq * 8), boff = lds_byte(wc * 32 + fr, fq * 8);
#define PG8_SA(b, h) (((b) * 2 + (h)) * HTB)
#define PG8_SB(b, h) ((4 + (b) * 2 + (h)) * HTB)
#define PG8_STAGE(bufoff, gbase, voff) do { _Pragma("unroll") for (int _i = 0; _i < 2; ++_i) \
        __builtin_amdgcn_global_load_lds((const unsigned*)((const char*)(gbase) + (voff)[_i]), (LAS unsigned*)(lds + (bufoff) + ldsw + _i * 8192), 16, 0, 0); } while (0)
#define PG8_LDA(dst, b, h) do { _Pragma("unroll") for (int m = 0; m < 4; ++m) _Pragma("unroll") for (int k = 0; k < 2; ++k) dst[m][k] = *(const LAS bf16x8*)(lds + PG8_SA(b, h) + aoff + m * 2048 + k * 1024); } while (0)
#define PG8_LDB(dst, b, h) do { _Pragma("unroll") for (int n = 0; n < 2; ++n) _Pragma("unroll") for (int k = 0; k < 2; ++k) dst[n][k] = *(const LAS bf16x8*)(lds + PG8_SB(b, h) + boff + n * 2048 + k * 1024); } while (0)
#define PG8_MMA(ai, bj, At, Bt) do { __builtin_amdgcn_s_setprio(1); _Pragma("unroll") for (int m = 0; m < 4; ++m) _Pragma("unroll") for (int n = 0; n < 2; ++n) _Pragma("unroll") for (int k = 0; k < 2; ++k) \
        acc[ai][bj][m][n] = __builtin_amdgcn_mfma_f32_16x16x32_bf16(Bt[n][k], At[m][k], acc[ai][bj][m][n], 0, 0, 0); __builtin_amdgcn_s_setprio(0); } while (0)
#define PG8_WAIT_V(n) asm volatile("s_waitcnt vmcnt(" #n ")" ::: "memory")
#define PG8_WAIT_L(n) asm volatile("s_waitcnt lgkmcnt(" #n ")" ::: "memory")
#define PG8_BAR __builtin_amdgcn_s_barrier()
#define PG8_SCHED __builtin_amdgcn_sched_barrier(0)
    Unit cur, nxt; int ui = 0;
    if (!S.next(0, cur)) return;
    f32x4 acc[2][2][4][2];
#pragma unroll
    for (int a = 0; a < 2; ++a)
#pragma unroll
        for (int b = 0; b < 2; ++b)
#pragma unroll
            for (int m = 0; m < 4; ++m)
#pragma unroll
                for (int n = 0; n < 2; ++n) acc[a][b][m][n] = (f32x4){0.f, 0.f, 0.f, 0.f};
    bf16x8 At[4][2], B0[2][2], B1[2][2];
    const char* cA = (const char*)g.A + (size_t)cur.pm * tstep; const char* cB = (const char*)g.Bt + (size_t)cur.pn * tstep;
    S.a_ready(cur);
    if constexpr (SP2) {
        PG8_STAGE(PG8_SB(0, 0), cB, voffB); PG8_STAGE(PG8_SB(0, 1), cB + hstep, voffB); PG8_STAGE(PG8_SA(0, 0), cA, voffA); PG8_STAGE(PG8_SA(0, 1), cA + hstep, voffA);
        if (wr == 1) PG8_BAR;
        PG8_WAIT_V(2); PG8_BAR;
        PG8_STAGE(PG8_SB(1, 0), cB + kstep, voffB); PG8_STAGE(PG8_SA(1, 0), cA + kstep, voffA); PG8_STAGE(PG8_SB(1, 1), cB + hstep + kstep, voffB);
        PG8_WAIT_V(6); PG8_BAR;
    } else {
        PG8_STAGE(PG8_SB(0, 0), cB, voffB); PG8_STAGE(PG8_SA(0, 0), cA, voffA); PG8_STAGE(PG8_SB(0, 1), cB + hstep, voffB); PG8_STAGE(PG8_SA(0, 1), cA + hstep, voffA);
        if (wr == 1) PG8_BAR;
        PG8_WAIT_V(4); PG8_BAR;
        PG8_STAGE(PG8_SB(1, 0), cB + kstep, voffB); PG8_STAGE(PG8_SA(1, 0), cA + kstep, voffA); PG8_STAGE(PG8_SB(1, 1), cB + hstep + kstep, voffB);
        PG8_WAIT_V(6); PG8_BAR;
    }
    for (;;) {
        const bool has_next = S.next(ui + 1, nxt);
        const char* nA = has_next ? (const char*)g.A + (size_t)nxt.pm * tstep : cA; const char* nB = has_next ? (const char*)g.Bt + (size_t)nxt.pn * tstep : cB;
        for (int t = 0; t < nt; t += 2) {
            const bool last = (t == nt - 2);
            const char* a1 = cA + (size_t)(t + 1) * kstep;
            const char* a2 = last ? nA : cA + (size_t)(t + 2) * kstep; const char* b2 = last ? nB : cB + (size_t)(t + 2) * kstep;
            const char* a3 = a2 + kstep; const char* b3 = b2 + kstep;
            if (last && has_next) S.a_ready(nxt);
            if constexpr (SP2) {
            PG8_LDB(B0, 0, 0); PG8_LDB(B1, 0, 1); PG8_SCHED; PG8_LDA(At, 0, 0); PG8_STAGE(PG8_SA(1, 1), a1 + hstep, voffA);
            PG8_WAIT_V(8); PG8_WAIT_L(0); PG8_BAR; PG8_MMA(0, 0, At, B0); PG8_MMA(0, 1, At, B1); PG8_BAR; PG8_SCHED;
            PG8_LDA(At, 0, 1); PG8_STAGE(PG8_SB(0, 0), b2, voffB); PG8_STAGE(PG8_SB(0, 1), b2 + hstep, voffB); PG8_STAGE(PG8_SA(0, 0), a2, voffA);
            PG8_WAIT_V(8); PG8_WAIT_L(0); PG8_BAR; PG8_MMA(1, 0, At, B0); PG8_MMA(1, 1, At, B1); PG8_BAR; PG8_SCHED;
            PG8_LDB(B0, 1, 0); PG8_LDB(B1, 1, 1); PG8_SCHED; PG8_LDA(At, 1, 0); PG8_STAGE(PG8_SA(0, 1), a2 + hstep, voffA);
            PG8_WAIT_V(8); PG8_WAIT_L(0); PG8_BAR; PG8_MMA(0, 0, At, B0); PG8_MMA(0, 1, At, B1); PG8_BAR; PG8_SCHED;
            PG8_LDA(At, 1, 1); PG8_STAGE(PG8_SB(1, 0), b3, voffB); PG8_STAGE(PG8_SB(1, 1), b3 + hstep, voffB); PG8_STAGE(PG8_SA(1, 0), a3, voffA);
            PG8_WAIT_V(8); PG8_WAIT_L(0); PG8_BAR; PG8_MMA(1, 0, At, B0); PG8_MMA(1, 1, At, B1); PG8_BAR; PG8_SCHED;
            } else {
            PG8_LDB(B0, 0, 0); PG8_SCHED; PG8_LDA(At, 0, 0); PG8_STAGE(PG8_SA(1, 1), a1 + hstep, voffA);
            PG8_WAIT_L(8); PG8_BAR; PG8_WAIT_L(0); PG8_MMA(0, 0, At, B0); PG8_BAR; PG8_SCHED;
            PG8_LDB(B1, 0, 1); PG8_STAGE(PG8_SB(0, 0), b2, voffB);
            PG8_BAR; PG8_WAIT_L(0); PG8_MMA(0, 1, At, B1); PG8_BAR;
            PG8_LDA(At, 0, 1); PG8_STAGE(PG8_SA(0, 0), a2, voffA);
            PG8_BAR; PG8_WAIT_L(0); PG8_MMA(1, 0, At, B0); PG8_BAR; PG8_SCHED;
            PG8_STAGE(PG8_SB(0, 1), b2 + hstep, voffB);
            PG8_WAIT_V(6); PG8_BAR; PG8_MMA(1, 1, At, B1); PG8_BAR;
            PG8_LDB(B0, 1, 0); PG8_SCHED; PG8_LDA(At, 1, 0); PG8_STAGE(PG8_SA(0, 1), a2 + hstep, voffA);
            PG8_WAIT_L(8); PG8_BAR; PG8_WAIT_L(0); PG8_MMA(0, 0, At, B0); PG8_BAR; PG8_SCHED;
            PG8_LDB(B1, 1, 1); PG8_STAGE(PG8_SB(1, 0), b3, voffB);
            PG8_BAR; PG8_WAIT_L(0); PG8_MMA(0, 1, At, B1); PG8_BAR;
            PG8_LDA(At, 1, 1); PG8_STAGE(PG8_SA(1, 0), a3, voffA);
            PG8_BAR; PG8_WAIT_L(0); PG8_MMA(1, 0, At, B0); PG8_BAR; PG8_SCHED;
            PG8_STAGE(PG8_SB(1, 1), b3 + hstep, voffB);
            PG8_WAIT_V(6); PG8_BAR; PG8_MMA(1, 1, At, B1); PG8_BAR;
            }
        }
        if constexpr (ALIGN_EPI) { if (wr == 0) PG8_BAR; }
        if constexpr (!Epi::AFTER_DRAIN) { E(acc, cur, wr, wc, fr, fq); S.done(cur); }
        if (!has_next) break;
#pragma unroll
        for (int a = 0; a < 2; ++a)
#pragma unroll
            for (int b = 0; b < 2; ++b)
#pragma unroll
                for (int m = 0; m < 4; ++m)
#pragma unroll
                    for (int n = 0; n < 2; ++n) acc[a][b][m][n] = (f32x4){0.f, 0.f, 0.f, 0.f};
        cur = nxt; cA = nA; cB = nB; ++ui;
        if constexpr (ALIGN_EPI) { if (wr == 1) PG8_BAR; }
    }
    PG8_WAIT_V(0);
    if constexpr (!ALIGN_EPI) { if (wr == 0) PG8_BAR; }
    PG8_BAR;
#undef PG8_SA
#undef PG8_SB
#undef PG8_STAGE
#undef PG8_LDA
#undef PG8_LDB
#undef PG8_MMA
#undef PG8_WAIT_V
#undef PG8_WAIT_L
#undef PG8_BAR
#undef PG8_SCHED
}
}

struct Params { const float* in[18]; float* out; unsigned char* ws; int ph_lo, ph_hi; };
enum { I_X = 0, I_C, I_NPRE, I_NPOST, I_WMOD, I_BMOD, I_WG, I_WU, I_WD, I_MIN, I_MQN, I_MQUP, I_MKVN, I_MKVUP, I_MWO, I_DIN, I_DWO, I_RB };

__device__ __forceinline__ unsigned f2bf(float f) { unsigned u = __builtin_bit_cast(unsigned, f); return (u + 0x7fffu + ((u >> 16) & 1u)) >> 16; }
__device__ __forceinline__ unsigned pk2(float lo, float hi) { return f2bf(lo) | (f2bf(hi) << 16); }

__device__ __forceinline__ void p0_transpose_item(const float* W, int K, int N, bf16_t* WT, int k0, int n0, int drow0, LAS float* scr, int lane) {
#pragma unroll 8
    for (int i = 0; i < 32; ++i) { const int kk = 2 * i + (lane >> 5); scr[kk * 33 + (lane & 31)] = W[(size_t)(k0 + kk) * N + n0 + (lane & 31)]; }
    asm volatile("s_waitcnt lgkmcnt(0)" ::: "memory");
    const int c = lane & 7;
#pragma unroll
    for (int j = 0; j < 4; ++j) { const int n = (lane >> 3) + 8 * j; const LAS float* s = scr + (8 * c) * 33 + n;
        u32x4 o; o.x = pk2(s[0 * 33], s[1 * 33]); o.y = pk2(s[2 * 33], s[3 * 33]); o.z = pk2(s[4 * 33], s[5 * 33]); o.w = pk2(s[6 * 33], s[7 * 33]);
        *(u32x4*)(WT + (size_t)(drow0 + n) * K + k0 + 8 * c) = o; }
    asm volatile("s_waitcnt lgkmcnt(0)" ::: "memory");
}
__device__ __forceinline__ int tr_drow(int kind, int n0) {
    if (kind == 1) return (n0 >> 7) * 256 + (n0 & 127);
    if (kind == 2) return (n0 >> 7) * 256 + 128 + (n0 & 127);
    if (kind == 3) { const int h = n0 >> 7, w = n0 & 127; return (w < 64) ? h * 64 + w : 1024 + h * 64 + (w - 64); }
    return n0;
}
__device__ __forceinline__ void sincos_d(double a, double& s, double& c) {
    const double TWO_PI = 6.283185307179586476925286766559;
    const double k = __builtin_rint(a / TWO_PI); const double x = a - k * TWO_PI, x2 = x * x;
    double ts = x, tc = 1.0; s = x; c = 1.0;
#pragma unroll 1
    for (int i = 1; i <= 16; ++i) { tc = -tc * x2 / (double)((2 * i - 1) * (2 * i)); ts = -ts * x2 / (double)((2 * i) * (2 * i + 1)); c += tc; s += ts; }
}
__device__ __forceinline__ void p0_prologue(int tid_in, const Params& P, LAS unsigned char* lds, int vcu, int G) {
    const int tid = tid_in, lane = tid & 63, wave = __builtin_amdgcn_readfirstlane(tid >> 6);
    unsigned char* ws = P.ws;
    {
        const int gt = vcu * 512 + tid, NT = G * 512;
        float* cosT = (float*)(ws + WS_COS); float* sinT = (float*)(ws + WS_SIN);
        for (int e = gt; e < SEQ * 16; e += NT) { const int pos = e >> 4, i = e & 15;
            const int iq = i >> 2, ir = i & 3;
            const double fb = (iq == 0) ? 1.0 : (iq == 1) ? 0.1 : (iq == 2) ? 0.01 : 0.001;
            const double fm = (ir == 0) ? 1.0 : (ir == 1) ? 0.5623413251903491 : (ir == 2) ? 0.31622776601683794 : 0.1778279410038923;
            const double freq = fb * fm;
            double s, c; sincos_d((double)pos * freq, s, c); cosT[e] = (float)c; sinT[e] = (float)s; }
        float* bT = (float*)(ws + WS_BIAS); const float* rb = P.in[I_RB];
        for (int e = gt; e < 3 * 16 * 192; e += NT) { const int g = e / (16 * 192), h = (e / 192) % 16, rel = (e % 192) - 32; const int dil = (g == 0) ? 1 : (g == 1) ? 4 : 16;
            float v = -INFINITY;
            if (rel >= 0 && rel <= 128) { const int dist = rel * dil; int bucket;
                if (dist < 16) bucket = dist; else { const float dd = (float)dist; int lg = 16 + (int)(__builtin_logf(dd / 16.0f) / __builtin_logf(128.0f) * 16.0f); bucket = lg < 31 ? lg : 31; }
                v = rb[bucket * 48 + g * 16 + h] * LOG2E; }
            bT[e] = v; }
    }
    {
        LAS float* sc = (LAS float*)lds;
        LAS float* red = (LAS float*)(lds + 32768);
        const float* c = P.in[I_C];
        for (int e = tid; e < 8 * 1024; e += 512) { const int b = e >> 10, k = e & 1023; const float v = c[e]; sc[k * 8 + b] = v / (1.0f + __expf(-v)); }
        __syncthreads();
        float* mod = (float*)(ws + WS_MOD);
        for (int it = vcu; it < 288; it += G) {
            const int l = it / 144, n0 = (it % 144) * 64;
            const float* W = P.in[I_WMOD] + (size_t)l * 1024 * 9216 + n0 + lane;
            float a[8];
#pragma unroll
            for (int b = 0; b < 8; ++b) a[b] = 0.f;
            const int k0 = wave * 128;
#pragma unroll 4
            for (int k = 0; k < 128; ++k) { const float w = W[(size_t)(k0 + k) * 9216];
                const f32x4 s0 = *(const LAS f32x4*)(sc + (k0 + k) * 8), s1 = *(const LAS f32x4*)(sc + (k0 + k) * 8 + 4);
                a[0] += s0[0] * w; a[1] += s0[1] * w; a[2] += s0[2] * w; a[3] += s0[3] * w; a[4] += s1[0] * w; a[5] += s1[1] * w; a[6] += s1[2] * w; a[7] += s1[3] * w; }
#pragma unroll
            for (int b = 0; b < 8; ++b) red[(wave * 8 + b) * 64 + lane] = a[b];
            __syncthreads();
            { const int b = tid >> 6; float s = 0.f;
#pragma unroll
              for (int w = 0; w < 8; ++w) s += red[(w * 8 + b) * 64 + lane];
              mod[(size_t)l * 8 * 9216 + (size_t)b * 9216 + n0 + lane] = s + P.in[I_BMOD][l * 9216 + n0 + lane]; }
            __syncthreads();
        }
    }
    __syncthreads();
    {
        LAS float* scr = (LAS float*)(lds + wave * 16384);
        bf16_t* WT = (bf16_t*)(ws + WS_WT);
        const int gw = vcu * 8 + wave, NGW = G * 8;
        constexpr int I_FFN = 1408, I_ALLFFN = 12 * I_FFN, I1 = 336, I2 = 288, I3 = 256, I4 = 512, I5 = 4608, I6 = 512;
        constexpr int NITEMS = I_ALLFFN + I1 + I2 + I3 + I4 + I5 + I6;
        for (int it = gw; it < NITEMS; it += NGW) {
            const float* src; bf16_t* dst; int K, N, kind = 0, r = it;
            if (r < I_ALLFFN) { const int mtx = r / I_FFN; r -= mtx * I_FFN; const int ffn = mtx / 3, which = mtx % 3;
                if (which == 0) { src = P.in[I_WG] + (size_t)ffn * 1024 * FF; K = 1024; N = FF; kind = 1; dst = WT + ffn * W_FFN_SZ + W_GU0; }
                else if (which == 1) { src = P.in[I_WU] + (size_t)ffn * 1024 * FF; K = 1024; N = FF; kind = 2; dst = WT + ffn * W_FFN_SZ + W_GU0; }
                else { src = P.in[I_WD] + (size_t)ffn * FF * 1024; K = FF; N = 1024; dst = WT + ffn * W_FFN_SZ + W_DN0; } }
            else { r -= I_ALLFFN;
                if (r < I1) { src = P.in[I_MIN]; K = 1024; N = 672; dst = WT + W_MLAIN; }
                else if ((r -= I1) < I2) { src = P.in[I_MQUP]; K = 384; N = 1536; dst = WT + W_QUP; }
                else if ((r -= I2) < I3) { src = P.in[I_MKVUP]; K = 256; N = 2048; kind = 3; dst = WT + W_KVUP; }
                else if ((r -= I3) < I4) { src = P.in[I_MWO]; K = 1024; N = 1024; dst = WT + W_MLAO; }
                else if ((r -= I4) < I5) { src = P.in[I_DIN]; K = 1024; N = 9216; dst = WT + W_DILIN; }
                else { r -= I5; src = P.in[I_DWO]; K = 1024; N = 1024; dst = WT + W_DILO; } }
            const int nblk = N / 32, kb = r / nblk, nb = r % nblk;
            p0_transpose_item(src, K, N, dst, kb * 64, nb * 32, tr_drow(kind, nb * 32), scr, lane);
        }
        { const int gt = vcu * 512 + tid, NT = G * 512; u32x4* z = (u32x4*)(WT + W_MLAIN + (size_t)672 * 1024);
          for (int e = gt; e < 96 * 1024 / 8; e += NT) z[e] = (u32x4){0u, 0u, 0u, 0u}; }
    }
}

__device__ __forceinline__ void norm_phase(int tid_in, const Params& P, int k, int vcu, int G) {
    const int tid = tid_in, lane = tid & 63, wave = __builtin_amdgcn_readfirstlane(tid >> 6);
    const int gw = vcu * 8 + wave, NGW = G * 8;
    const float* mod = (const float*)(P.ws + WS_MOD);
    const float* Y = (const float*)(P.ws + WS_Y);
    bf16_t* HN = (bf16_t*)(P.ws + WS_HN);
    const float* xin = (k <= 1) ? P.in[I_X] : P.out;
    const bool upd = (k >= 1), pre = (k <= 5);
    const int su = k - 1, lu = su / 3, subu = su % 3;
    const int lp = k / 3, subp = k % 3;
    const float rw = (subu == 1) ? 1.0f : 0.5f;
    for (int row = gw; row < M; row += NGW) {
        const int b = row >> 11;
        f32x4 x[4];
#pragma unroll
        for (int j = 0; j < 4; ++j) x[j] = *((const f32x4*)(xin + (size_t)row * D) + lane + 64 * j);
        if (upd) {
            f32x4 y[4]; float ss = 0.f;
#pragma unroll
            for (int j = 0; j < 4; ++j) { y[j] = *((const f32x4*)(Y + (size_t)row * D) + lane + 64 * j); ss += (y[j][0] * y[j][0] + y[j][1] * y[j][1]) + (y[j][2] * y[j][2] + y[j][3] * y[j][3]); }
            const float rstd = 1.0f / sqrtf(wave_sum(ss) * (1.0f / D) + EPS);
            const float* gate = mod + (size_t)lu * 8 * 9216 + (size_t)b * 9216 + subu * 3072 + 2048;
            const float* post = P.in[I_NPOST] + (lu * 3 + subu) * D;
#pragma unroll
            for (int j = 0; j < 4; ++j) { const f32x4 g = *((const f32x4*)gate + lane + 64 * j), pg = *((const f32x4*)post + lane + 64 * j);
                x[j] = x[j] + (g * rw) * ((y[j] * rstd) * pg);
                *((f32x4*)(P.out + (size_t)row * D) + lane + 64 * j) = x[j]; }
        }
        if (pre) {
            float ss = 0.f;
#pragma unroll
            for (int j = 0; j < 4; ++j) ss += (x[j][0] * x[j][0] + x[j][1] * x[j][1]) + (x[j][2] * x[j][2] + x[j][3] * x[j][3]);
            const float rstd = 1.0f / sqrtf(wave_sum(ss) * (1.0f / D) + EPS);
            const float* shift = mod + (size_t)lp * 8 * 9216 + (size_t)b * 9216 + subp * 3072;
            const float* scale = shift + 1024;
            const float* pg_ = P.in[I_NPRE] + (lp * 3 + subp) * D;
#pragma unroll
            for (int j = 0; j < 4; ++j) { const f32x4 sh = *((const f32x4*)shift + lane + 64 * j), scl = *((const f32x4*)scale + lane + 64 * j), pg = *((const f32x4*)pg_ + lane + 64 * j);
                const f32x4 h = ((x[j] * rstd) * pg) * (scl + 1.0f) + sh;
                u32x2 w; w.x = cvt_pk_bf16(h[0], h[1]); w.y = cvt_pk_bf16(h[2], h[3]);
                *((u32x2*)(HN + (size_t)row * D) + lane + 64 * j) = w; }
        }
    }
}

__device__ __forceinline__ void mla_row_phase(int tid_in, const Params& P, int vcu, int G) {
    const int tid = tid_in, lane = tid & 63, wave = __builtin_amdgcn_readfirstlane(tid >> 6);
    const int gw = vcu * 8 + wave, NGW = G * 8;
    const float* LAT = (const float*)(P.ws + WS_LAT);
    bf16_t* CQN = (bf16_t*)(P.ws + WS_CQN); bf16_t* CKVN = (bf16_t*)(P.ws + WS_CKVN); bf16_t* KR = (bf16_t*)(P.ws + WS_KR);
    const float* cosT = (const float*)(P.ws + WS_COS); const float* sinT = (const float*)(P.ws + WS_SIN);
    const float* qn = P.in[I_MQN]; const float* kvn = P.in[I_MKVN];
    for (int row = gw; row < M; row += NGW) {
        const float* lr = LAT + (size_t)row * 768;
        const f32x4 a = *((const f32x4*)lr + lane); const f32x2 a2 = *((const f32x2*)(lr + 256) + lane);
        const f32x4 kv = *((const f32x4*)(lr + 384) + lane);
        float x1 = 0.f, x2 = 0.f; if (lane < 16) { x1 = lr[640 + lane]; x2 = lr[656 + lane]; }
        float ssq = (a[0] * a[0] + a[1] * a[1]) + (a[2] * a[2] + a[3] * a[3]) + (a2[0] * a2[0] + a2[1] * a2[1]);
        float ssk = (kv[0] * kv[0] + kv[1] * kv[1]) + (kv[2] * kv[2] + kv[3] * kv[3]);
        const float rq = 1.0f / sqrtf(wave_sum(ssq) * (1.0f / 384.0f) + EPS), rk = 1.0f / sqrtf(wave_sum(ssk) * (1.0f / 256.0f) + EPS);
        const f32x4 g = *((const f32x4*)qn + lane); const f32x2 g2 = *((const f32x2*)(qn + 256) + lane); const f32x4 gk = *((const f32x4*)kvn + lane);
        u32x2 w; w.x = cvt_pk_bf16(a[0] * rq * g[0], a[1] * rq * g[1]); w.y = cvt_pk_bf16(a[2] * rq * g[2], a[3] * rq * g[3]);
        *((u32x2*)(CQN + (size_t)row * 384) + lane) = w;
        *((unsigned*)(CQN + (size_t)row * 384 + 256) + lane) = cvt_pk_bf16(a2[0] * rq * g2[0], a2[1] * rq * g2[1]);
        u32x2 wk; wk.x = cvt_pk_bf16(kv[0] * rk * gk[0], kv[1] * rk * gk[1]); wk.y = cvt_pk_bf16(kv[2] * rk * gk[2], kv[3] * rk * gk[3]);
        *((u32x2*)(CKVN + (size_t)row * 256) + lane) = wk;
        if (lane < 16) { const int pos = row & (SEQ - 1); const float c = cosT[pos * 16 + lane], s = sinT[pos * 16 + lane];
            KR[(size_t)row * 32 + lane] = (bf16_t)f2bf(x1 * c - x2 * s); KR[(size_t)row * 32 + 16 + lane] = (bf16_t)f2bf(x1 * s + x2 * c); }
    }
}

__device__ __forceinline__ int crow(int r, int hi) { return (r & 3) + 8 * (r >> 2) + 4 * hi; }
typedef short v4i16_t __attribute__((ext_vector_type(4)));
__device__ __forceinline__ s16x4 vtr(const LAS unsigned char* p) { return __builtin_bit_cast(s16x4, __builtin_amdgcn_ds_read_tr16_b64_v4i16((LAS v4i16_t*)p)); }
#define MFMA32(a, b, c) __builtin_amdgcn_mfma_f32_32x32x16_bf16((a), (b), (c), 0, 0, 0)

template <bool TWO> __device__ __forceinline__ void softmax_update(f32x16& p0, f32x16& p1, float& m, float& l, f32x16& o0, f32x16& o1) {
    float mx = p0[0];
#pragma unroll
    for (int r = 1; r < 16; ++r) mx = fmaxf(mx, p0[r]);
    if (TWO) {
#pragma unroll
        for (int r = 0; r < 16; ++r) mx = fmaxf(mx, p1[r]); }
    mx = fmaxf(mx, __shfl_xor(mx, 32));
    const float mn = fmaxf(m, mx);
    const float alpha = __builtin_amdgcn_exp2f(m - mn);
    m = mn;
    float s = 0.f;
#pragma unroll
    for (int r = 0; r < 16; ++r) { p0[r] = __builtin_amdgcn_exp2f(p0[r] - mn); s += p0[r]; }
    if (TWO) {
#pragma unroll
        for (int r = 0; r < 16; ++r) { p1[r] = __builtin_amdgcn_exp2f(p1[r] - mn); s += p1[r]; } }
    l = l * alpha + s;
#pragma unroll
    for (int r = 0; r < 16; ++r) { o0[r] *= alpha; o1[r] *= alpha; }
}
__device__ __forceinline__ bf16x8 pack8(const f32x16& p, int b) {
    u32x4 w; w.x = cvt_pk_bf16(p[b], p[b + 1]); w.y = cvt_pk_bf16(p[b + 2], p[b + 3]); w.z = cvt_pk_bf16(p[b + 4], p[b + 5]); w.w = cvt_pk_bf16(p[b + 6], p[b + 7]);
    return __builtin_bit_cast(bf16x8, w);
}
__device__ __forceinline__ bf16x8 vfrag(const LAS unsigned char* p) { const s16x4 lo = vtr(p), hi = vtr(p + 512); return (bf16x8){lo[0], lo[1], lo[2], lo[3], hi[0], hi[1], hi[2], hi[3]}; }

constexpr int MA_KROW = 208, MA_KB = 64 * MA_KROW  , MA_VB = 8192, MA_K0 = 0, MA_V0 = 2 * MA_KB, MA_ST = MA_V0 + 2 * MA_VB  , MA_STW = 32 * 144;
__device__ __forceinline__ void mla_attn_phase(int tid_in, const Params& P, LAS unsigned char* lds, int vcu) {
    const int tid = tid_in, lane = tid & 63, wid = __builtin_amdgcn_readfirstlane(tid >> 6), r32 = lane & 31, hi = lane >> 5;
    const bf16_t* Q = (const bf16_t*)(P.ws + WS_Q); const bf16_t* KN = (const bf16_t*)(P.ws + WS_KN); const bf16_t* KR = (const bf16_t*)(P.ws + WS_KR);
    const bf16_t* V = (const bf16_t*)(P.ws + WS_V); bf16_t* O = (bf16_t*)(P.ws + WS_HN);
    const int bh = vcu >> 1, sg = vcu & 1, b = bh >> 4, h = bh & 15;
    const size_t rowbase = (size_t)b * SEQ;
    const int krow = tid >> 3, kch = tid & 7, rrow = tid >> 2, rch = tid & 3;
    const unsigned kwoff = krow * MA_KROW + kch * 16, rwoff = rrow * MA_KROW + 128 + rch * 16;
    const unsigned vwoff = (kch >> 2) * 4096 + (krow >> 4) * 1024 + (krow & 15) * 64 + (kch & 3) * 16;
    const unsigned vrd = ((lane >> 4) & 1) * 32 + (lane & 3) * 8 + (4 * hi + ((lane & 15) >> 2)) * 64;
    for (int ui = 0; ui < 4; ++ui) {
        const int qb = (ui == 0) ? sg : (ui == 1) ? 7 - sg : (ui == 2) ? 2 + sg : 5 - sg;
        const int q0w = qb * 256 + wid * 32, qabs = q0w + r32;
        const int NT = 4 * (qb + 1);
        bf16x8 qf[6];
        { const bf16_t* qp = Q + (rowbase + qabs) * 1536 + h * 96 + hi * 8;
#pragma unroll
          for (int s = 0; s < 6; ++s) qf[s] = *(const bf16x8*)(qp + s * 16); }
        u32x4 gk, gr = (u32x4){0u, 0u, 0u, 0u}, gv;
        { const size_t r0 = rowbase;
          gk = *(const u32x4*)(KN + (r0 + krow) * 1024 + h * 64 + kch * 8); gv = *(const u32x4*)(V + (r0 + krow) * 1024 + h * 64 + kch * 8);
          if (tid < 256) gr = *(const u32x4*)(KR + (r0 + rrow) * 32 + rch * 8); }
        *(LAS u32x4*)(lds + MA_K0 + kwoff) = gk; *(LAS u32x4*)(lds + MA_V0 + vwoff) = gv; if (tid < 256) *(LAS u32x4*)(lds + MA_K0 + rwoff) = gr;
        __syncthreads();
        float m = -INFINITY, l = 0.f; f32x16 o0 = {}, o1 = {};
        for (int t = 0; t < NT; ++t) {
            const int cur = t & 1, kv0 = t * 64;
            if (t + 1 < NT) { const size_t r0 = rowbase + (size_t)(t + 1) * 64;
                gk = *(const u32x4*)(KN + (r0 + krow) * 1024 + h * 64 + kch * 8); gv = *(const u32x4*)(V + (r0 + krow) * 1024 + h * 64 + kch * 8);
                if (tid < 256) gr = *(const u32x4*)(KR + (r0 + rrow) * 32 + rch * 8); }
            if (kv0 <= q0w + 31) {
                const LAS unsigned char* kb = lds + MA_K0 + cur * MA_KB + r32 * MA_KROW + hi * 16;
                const LAS unsigned char* vb = lds + MA_V0 + cur * MA_VB + vrd;
                f32x16 p0 = {}, p1 = {};
#pragma unroll
                for (int s = 0; s < 6; ++s) { const bf16x8 a0 = *(const LAS bf16x8*)(kb + s * 32), a1 = *(const LAS bf16x8*)(kb + 32 * MA_KROW + s * 32);
                    p0 = MFMA32(a0, qf[s], p0); p1 = MFMA32(a1, qf[s], p1); }
                if (kv0 + 63 > q0w) {
#pragma unroll
                    for (int r = 0; r < 16; ++r) { const int ka = kv0 + crow(r, hi); if (ka > qabs) p0[r] = -INFINITY; if (ka + 32 > qabs) p1[r] = -INFINITY; } }
                softmax_update<true>(p0, p1, m, l, o0, o1);
                const bf16x8 pf0 = pack8(p0, 0), pf1 = pack8(p0, 8), pf2 = pack8(p1, 0), pf3 = pack8(p1, 8);
                o0 = MFMA32(vfrag(vb + 0 * 1024), pf0, o0); o0 = MFMA32(vfrag(vb + 1 * 1024), pf1, o0); o0 = MFMA32(vfrag(vb + 2 * 1024), pf2, o0); o0 = MFMA32(vfrag(vb + 3 * 1024), pf3, o0);
                o1 = MFMA32(vfrag(vb + 4096 + 0 * 1024), pf0, o1); o1 = MFMA32(vfrag(vb + 4096 + 1 * 1024), pf1, o1); o1 = MFMA32(vfrag(vb + 4096 + 2 * 1024), pf2, o1); o1 = MFMA32(vfrag(vb + 4096 + 3 * 1024), pf3, o1);
            }
            if (t + 1 < NT) { const int nx = cur ^ 1;
                *(LAS u32x4*)(lds + MA_K0 + nx * MA_KB + kwoff) = gk; *(LAS u32x4*)(lds + MA_V0 + nx * MA_VB + vwoff) = gv; if (tid < 256) *(LAS u32x4*)(lds + MA_K0 + nx * MA_KB + rwoff) = gr; }
            __syncthreads();
        }
        l += __shfl_xor(l, 32);
        const float rl = 1.0f / l;
        LAS unsigned char* st = lds + MA_ST + wid * MA_STW;
#pragma unroll
        for (int r = 0; r < 16; ++r) { const int d = crow(r, hi);
            *(LAS bf16_t*)(st + r32 * 144 + d * 2) = (bf16_t)f2bf(o0[r] * rl); *(LAS bf16_t*)(st + r32 * 144 + (32 + d) * 2) = (bf16_t)f2bf(o1[r] * rl); }
        asm volatile("s_waitcnt lgkmcnt(0)" ::: "memory");
#pragma unroll
        for (int i = 0; i < 4; ++i) { const int row = i * 8 + (lane >> 3), ch = lane & 7; const u32x4 v = *(const LAS u32x4*)(st + row * 144 + ch * 16);
            *(u32x4*)(O + (rowbase + q0w + row) * 1024 + h * 64 + ch * 8) = v; }
        __syncthreads();
    }
}

constexpr int DA_WB = 8704;
constexpr int DA_TAB = 8 * DA_WB;
__device__ __forceinline__ void dil_attn_phase(int tid_in, const Params& P, LAS unsigned char* lds, int g, int vcu, int G) {
    const int tid = tid_in, lane = tid & 63, wid = __builtin_amdgcn_readfirstlane(tid >> 6), r32 = lane & 31, hi = lane >> 5;
    const bf16_t* PR = (const bf16_t*)(P.ws + WS_PROJ);
    float* SO = (float*)(P.ws + WS_SO); float* SM = (float*)(P.ws + WS_SM); float* SL = (float*)(P.ws + WS_SL);
    bf16_t* O = (bf16_t*)(P.ws + WS_HN);
    const int lr = (g == 0) ? 0 : (g == 1) ? 2 : 4, r = 1 << lr;
    const int nms = (SEQ >> lr) >> 5;
    { const float* bT = (const float*)(P.ws + WS_BIAS) + g * 16 * 192; LAS float* tab = (LAS float*)(lds + DA_TAB);
      for (int e = tid; e < 16 * 192; e += 512) tab[e] = bT[e]; }
    __syncthreads();
    LAS unsigned char* wl = lds + wid * DA_WB;
    LAS unsigned char* kl = wl; LAS unsigned char* vl = wl + 4608;
    const int lrow = lane >> 3, lch = lane & 7;
    const unsigned vrd = ((lane >> 4) & 1) * 32 + (lane & 3) * 8 + (4 * hi + ((lane & 15) >> 2)) * 64;
    const int gw = vcu * 8 + wid, NGW = G * 8;
    for (int s = gw; s < 8192; s += NGW) {
        const int ms = s % nms; int t_ = s / nms; const int rho = t_ % r; t_ /= r; const int h = t_ & 15, b = t_ >> 4;
        const int m0 = ms * 32;
        const size_t rowb = (size_t)b * SEQ;
        const size_t qrow = rowb + (size_t)r * (m0 + r32) + rho;
        bf16x8 qf[4];
#pragma unroll
        for (int s4 = 0; s4 < 4; ++s4) qf[s4] = *(const bf16x8*)(PR + qrow * 3072 + h * 64 + s4 * 16 + hi * 8);
        float m = -INFINITY, l = 0.f; f32x16 o0 = {}, o1 = {};
        if (g > 0) {
#pragma unroll
            for (int j = 0; j < 8; ++j) { const int q = (lane >> 4) + 4 * j, c4 = lane & 15; const size_t tr = rowb + (size_t)r * (m0 + q) + rho;
                *(LAS f32x4*)(wl + (q * 68 + c4 * 4) * 4) = *(const f32x4*)(SO + tr * 1024 + h * 64 + c4 * 4); }
#pragma unroll
            for (int rr = 0; rr < 16; ++rr) { const int d = crow(rr, hi); o0[rr] = *(const LAS float*)(wl + (r32 * 68 + d) * 4); o1[rr] = *(const LAS float*)(wl + (r32 * 68 + 32 + d) * 4); }
            m = SM[qrow * 16 + h]; l = hi ? 0.f : SL[qrow * 16 + h];
        }
        const int i0 = (m0 >= 128) ? 0 : ((128 - m0) >> 5);
        u32x4 gk[4], gv[4];
        { const int kt0 = m0 - 128 + 32 * i0;
#pragma unroll
          for (int j = 0; j < 4; ++j) { const size_t kr_ = rowb + (size_t)r * (kt0 + lrow + 8 * j) + rho;
              gk[j] = *(const u32x4*)(PR + kr_ * 3072 + 1024 + h * 64 + lch * 8); gv[j] = *(const u32x4*)(PR + kr_ * 3072 + 2048 + h * 64 + lch * 8); } }
        const LAS float* tabh = (const LAS float*)(lds + DA_TAB) + h * 192;
        for (int i = i0; i < 5; ++i) {
#pragma unroll
            for (int j = 0; j < 4; ++j) { const int k = lrow + 8 * j;
                *(LAS u32x4*)(kl + k * 144 + lch * 16) = gk[j];
                *(LAS u32x4*)(vl + (lch >> 2) * 2048 + (k >> 4) * 1024 + (k & 15) * 64 + (lch & 3) * 16) = gv[j]; }
            if (i + 1 < 5) { const int kt0 = m0 - 128 + 32 * (i + 1);
#pragma unroll
                for (int j = 0; j < 4; ++j) { const size_t kr_ = rowb + (size_t)r * (kt0 + lrow + 8 * j) + rho;
                    gk[j] = *(const u32x4*)(PR + kr_ * 3072 + 1024 + h * 64 + lch * 8); gv[j] = *(const u32x4*)(PR + kr_ * 3072 + 2048 + h * 64 + lch * 8); } }
            f32x16 p0 = {}, p1 = {};
#pragma unroll
            for (int s4 = 0; s4 < 4; ++s4) { const bf16x8 a0 = *(const LAS bf16x8*)(kl + r32 * 144 + s4 * 32 + hi * 16); p0 = MFMA32(a0, qf[s4], p0); }
            { const int base = 160 - 32 * i + r32 - 4 * hi;
#pragma unroll
              for (int rr = 0; rr < 16; ++rr) p0[rr] += tabh[base - ((rr & 3) + 8 * (rr >> 2))]; }
            softmax_update<false>(p0, p1, m, l, o0, o1);
            const bf16x8 pf0 = pack8(p0, 0), pf1 = pack8(p0, 8);
            o0 = MFMA32(vfrag(vl + vrd), pf0, o0); o0 = MFMA32(vfrag(vl + vrd + 1024), pf1, o0);
            o1 = MFMA32(vfrag(vl + vrd + 2048), pf0, o1); o1 = MFMA32(vfrag(vl + vrd + 2048 + 1024), pf1, o1);
        }
        const float lt = l + __shfl_xor(l, 32);
        if (g < 2) {
#pragma unroll
            for (int rr = 0; rr < 16; ++rr) { const int d = crow(rr, hi); *(LAS float*)(wl + (r32 * 68 + d) * 4) = o0[rr]; *(LAS float*)(wl + (r32 * 68 + 32 + d) * 4) = o1[rr]; }
#pragma unroll
            for (int j = 0; j < 8; ++j) { const int q = (lane >> 4) + 4 * j, c4 = lane & 15; const size_t tr = rowb + (size_t)r * (m0 + q) + rho;
                *(f32x4*)(SO + tr * 1024 + h * 64 + c4 * 4) = *(const LAS f32x4*)(wl + (q * 68 + c4 * 4) * 4); }
            if (hi == 0) { SM[qrow * 16 + h] = m; SL[qrow * 16 + h] = lt; }
        } else {
            const float rl = 1.0f / lt;
#pragma unroll
            for (int rr = 0; rr < 16; ++rr) { const int d = crow(rr, hi);
                *(LAS bf16_t*)(wl + r32 * 144 + d * 2) = (bf16_t)f2bf(o0[rr] * rl); *(LAS bf16_t*)(wl + r32 * 144 + (32 + d) * 2) = (bf16_t)f2bf(o1[rr] * rl); }
#pragma unroll
            for (int j = 0; j < 4; ++j) { const int q = lrow + 8 * j; const size_t tr = rowb + (size_t)r * (m0 + q) + rho;
                *(u32x4*)(O + tr * 1024 + h * 64 + lch * 8) = *(const LAS u32x4*)(wl + q * 144 + lch * 16); }
        }
    }
    __syncthreads();
}

enum { T_PRO = 0, T_NORM, T_GU, T_F32, T_MLAROW, T_QKVUP, T_MLAATT, T_DILPROJ, T_DILATT };
constexpr int N_PHASES = 28;
__device__ __forceinline__ void phase_desc(int p, int& type, int& a) {
    switch (p) {
        case 0: type = T_PRO; a = 0; break;
        case 1: type = T_NORM; a = 0; break;
        case 2: type = T_GU; a = 0; break;   case 3: type = T_F32; a = 0; break;   case 4: type = T_NORM; a = 1; break;
        case 5: type = T_F32; a = 4; break;  case 6: type = T_MLAROW; a = 0; break; case 7: type = T_QKVUP; a = 0; break; case 8: type = T_MLAATT; a = 0; break;
        case 9: type = T_F32; a = 5; break;  case 10: type = T_NORM; a = 2; break;
        case 11: type = T_GU; a = 1; break;  case 12: type = T_F32; a = 1; break;  case 13: type = T_NORM; a = 3; break;
        case 14: type = T_GU; a = 2; break;  case 15: type = T_F32; a = 2; break;  case 16: type = T_NORM; a = 4; break;
        case 17: type = T_DILPROJ; a = 0; break; case 18: type = T_DILATT; a = 0; break;
        case 19: type = T_DILPROJ; a = 1; break; case 20: type = T_DILATT; a = 1; break;
        case 21: type = T_DILPROJ; a = 2; break; case 22: type = T_DILATT; a = 2; break;
        case 23: type = T_F32; a = 6; break; case 24: type = T_NORM; a = 5; break;
        case 25: type = T_GU; a = 3; break;  case 26: type = T_F32; a = 3; break;
        default: type = T_NORM; a = 6; break;
    }
}

__global__ void __launch_bounds__(512, 2) mk_fwd(Params P0) {
    extern __shared__ __attribute__((aligned(16))) unsigned char lds_raw[];
    LAS unsigned char* lds = (LAS unsigned char*)lds_raw;
    for (int p = P0.ph_lo; p < P0.ph_hi; ++p) {
        int type, a; phase_desc(p, type, a);
        int tid = threadIdx.x; asm volatile("" : "+v"(tid));
        size_t z_ = 0; asm volatile("" : "+s"(z_));
        int G = gridDim.x, bx = blockIdx.x; asm volatile("" : "+s"(G), "+s"(bx));
        const int vcu = (G % 8 == 0) ? (bx % 8) * (G / 8) + bx / 8 : bx;
        Params P;
#pragma unroll
        for (int i = 0; i < 18; ++i) P.in[i] = P0.in[i] + z_;
        P.out = P0.out + z_; P.ws = P0.ws + z_; P.ph_lo = 0; P.ph_hi = 0;
        unsigned char* ws = P.ws;
        bf16_t* WT = (bf16_t*)(ws + WS_WT);
#ifdef MK_ONLY
        if (type != MK_ONLY) continue;
#endif
        switch (type) {
            case T_PRO: p0_prologue(tid, P, lds, vcu, G); break;
            case T_NORM: norm_phase(tid, P, a, vcu, G); break;
            case T_GU: {
                pg8::Gemm g{(const bf16_t*)(ws + WS_HN), WT + (size_t)a * W_FFN_SZ + W_GU0, M, 2 * FF, D};
                pg8::StaticOrder S; S.init(M, 2 * FF, G, bx);
                pg8::EpiSwiGLU E{(bf16_t*)(ws + WS_ACT), FF};
                pg8::gemm_phase<pg8::EpiSwiGLU, pg8::StaticOrder, true, true>(tid, lds, g, S, E);
            } break;
            case T_F32: {
                pg8::Gemm g; pg8::EpiF32 E;
                if (a < 4) { g = pg8::Gemm{(const bf16_t*)(ws + WS_ACT), WT + (size_t)a * W_FFN_SZ + W_DN0, M, D, FF}; E = pg8::EpiF32{(float*)(ws + WS_Y), D}; }
                else if (a == 4) { g = pg8::Gemm{(const bf16_t*)(ws + WS_HN), WT + W_MLAIN, M, 768, D}; E = pg8::EpiF32{(float*)(ws + WS_LAT), 768}; }
                else if (a == 5) { g = pg8::Gemm{(const bf16_t*)(ws + WS_HN), WT + W_MLAO, M, D, D}; E = pg8::EpiF32{(float*)(ws + WS_Y), D}; }
                else { g = pg8::Gemm{(const bf16_t*)(ws + WS_HN), WT + W_DILO, M, D, D}; E = pg8::EpiF32{(float*)(ws + WS_Y), D}; }
                pg8::StaticOrder S; S.init(M, g.N, G, bx);
                pg8::gemm_phase<pg8::EpiF32, pg8::StaticOrder, true, true>(tid, lds, g, S, E);
            } break;
            case T_MLAROW: mla_row_phase(tid, P, vcu, G); break;
            case T_QKVUP: {
#ifndef MK_NOQ
                { pg8::Gemm g{(const bf16_t*)(ws + WS_CQN), WT + W_QUP, M, 1536, 384};
                  pg8::StaticOrder S; S.init(M, 1536, G, bx);
                  pg8::EpiQ E{(bf16_t*)(ws + WS_Q), (const float*)(ws + WS_COS), (const float*)(ws + WS_SIN), C2_MLA};
                  pg8::gemm_phase<pg8::EpiQ, pg8::StaticOrder, true, true>(tid, lds, g, S, E); }
#endif
#ifndef MK_NOKV
                { pg8::Gemm g{(const bf16_t*)(ws + WS_CKVN), WT + W_KVUP, M, 2048, 256};
                  pg8::StaticOrder S; S.init(M, 2048, G, bx);
                  pg8::EpiBf16 E{(bf16_t*)(ws + WS_KN), D, 1024, (size_t)(WS_V - WS_KN) / 2, 1.0f};
                  pg8::gemm_phase<pg8::EpiBf16, pg8::StaticOrder, true, true>(tid, lds, g, S, E); }
#endif
            } break;
            case T_MLAATT: mla_attn_phase(tid, P, lds, vcu); break;
            case T_DILPROJ: {
                pg8::Gemm g{(const bf16_t*)(ws + WS_HN), WT + W_DILIN + (size_t)a * 3072 * 1024, M, 3072, D};
                pg8::StaticOrder S; S.init(M, 3072, G, bx);
                pg8::EpiBf16 E{(bf16_t*)(ws + WS_PROJ), 3072, 1024, (size_t)1024, C2_DIL};
                pg8::gemm_phase<pg8::EpiBf16, pg8::StaticOrder, true, true>(tid, lds, g, S, E);
            } break;
            case T_DILATT: dil_attn_phase(tid, P, lds, a, vcu, G); break;
        }
        if (p + 1 < P0.ph_hi) cg::this_grid().sync();
    }
}

extern "C" void kernel_launch(void* const* d_in, const int* in_sizes, int n_in, void* d_out, int out_size, void* d_ws, size_t ws_size, hipStream_t stream) {
    static int grid = 0;
    if (grid == 0) {
        if (n_in != 18 || in_sizes[0] != M * D || out_size != M * D || ws_size < WS_END) { fprintf(stderr, "kernel_launch: unexpected shapes (n_in %d, in0 %d, out %d, ws %zu)\n", n_in, n_in > 0 ? in_sizes[0] : -1, out_size, ws_size); grid = -1; return; }
        int dev = 0, cus = 0, per_cu = 0;
        if (hipGetDevice(&dev) != hipSuccess || hipDeviceGetAttribute(&cus, hipDeviceAttributeMultiprocessorCount, dev) != hipSuccess) { grid = -1; return; }
        if (hipFuncSetAttribute((const void*)mk_fwd, hipFuncAttributeMaxDynamicSharedMemorySize, LDS_BYTES) != hipSuccess) { fprintf(stderr, "kernel_launch: hipFuncSetAttribute failed\n"); grid = -1; return; }
        if (hipOccupancyMaxActiveBlocksPerMultiprocessor(&per_cu, (const void*)mk_fwd, 512, LDS_BYTES) != hipSuccess || per_cu < 1) { fprintf(stderr, "kernel_launch: occupancy query says %d\n", per_cu); (void)hipGetLastError(); per_cu = 1; }
        grid = cus;
        fprintf(stderr, "kernel_launch: cus %d per_cu %d grid %d ws %zu\n", cus, per_cu, grid, ws_size);
    }
    if (grid < 0) return;
    Params p{};
    for (int i = 0; i < 18; ++i) p.in[i] = (const float*)d_in[i];
    p.out = (float*)d_out; p.ws = (unsigned char*)d_ws;
#if MK_ONE_LAUNCH
    p.ph_lo = 0; p.ph_hi = N_PHASES;
    { void* args[] = {&p}; hipError_t e = hipLaunchCooperativeKernel((const void*)mk_fwd, dim3(grid), dim3(512), args, LDS_BYTES, stream);
      if (e != hipSuccess) fprintf(stderr, "cooperative launch failed: %s\n", hipGetErrorString(e)); }
#else
    for (int ph = 0; ph < N_PHASES; ++ph) {
        p.ph_lo = ph; p.ph_hi = ph + 1;
        void* args[] = {&p}; hipError_t e = hipLaunchCooperativeKernel((const void*)mk_fwd, dim3(grid), dim3(512), args, LDS_BYTES, stream);
        if (e != hipSuccess) { fprintf(stderr, "cooperative launch %d failed: %s\n", ph, hipGetErrorString(e)); break; }
    }
#endif
}
```

```cpp
#include <hip/hip_runtime.h>
#include <hip/hip_cooperative_groups.h>
#include <cstdio>
#include <cstdint>
namespace cg = cooperative_groups;

#ifndef MK_ONE_LAUNCH
#define MK_ONE_LAUNCH 1
#endif

#define LAS __attribute__((address_space(3)))
typedef unsigned short bf16_t;
typedef short bf16x8 __attribute__((ext_vector_type(8)));
typedef short s16x4 __attribute__((ext_vector_type(4)));
typedef float f32x2 __attribute__((ext_vector_type(2)));
typedef float f32x4 __attribute__((ext_vector_type(4)));
typedef float f32x16 __attribute__((ext_vector_type(16)));
typedef unsigned u32x2 __attribute__((ext_vector_type(2)));
typedef unsigned u32x4 __attribute__((ext_vector_type(4)));

constexpr int M = 16384, D = 1024, SEQ = 2048, NBATCH = 8, FF = 2816;
constexpr float EPS = 1e-6f;
constexpr float LOG2E = 1.4426950408889634f;
constexpr float C2_MLA = 0.10206207261596575f * LOG2E;
constexpr float C2_DIL = 0.125f * LOG2E;

constexpr size_t MiB = 1u << 20;
constexpr size_t WS_CTL = 0;
constexpr size_t WS_WT = 1 * MiB;
constexpr size_t WS_MOD = 100 * MiB;
constexpr size_t WS_COS = 101 * MiB;
constexpr size_t WS_SIN = WS_COS + 131072;
constexpr size_t WS_BIAS = 101 * MiB + 512 * 1024;
constexpr size_t WS_HN = 102 * MiB;
constexpr size_t WS_ACT = 134 * MiB;
constexpr size_t WS_Y = 222 * MiB;
constexpr size_t WS_LAT = 134 * MiB;
constexpr size_t WS_Q = 134 * MiB;
constexpr size_t WS_CQN = 182 * MiB;
constexpr size_t WS_CKVN = 194 * MiB;
constexpr size_t WS_KN = 202 * MiB;
constexpr size_t WS_V = 234 * MiB;
constexpr size_t WS_KR = 266 * MiB;
constexpr size_t WS_PROJ = 134 * MiB;
constexpr size_t WS_SO = 230 * MiB;
constexpr size_t WS_SM = 294 * MiB;
constexpr size_t WS_SL = 295 * MiB;
constexpr size_t WS_END = 296 * MiB;

constexpr size_t W_FFN_SZ = (size_t)5632 * 1024 + (size_t)1024 * 2816;
constexpr size_t W_GU0 = 0, W_DN0 = (size_t)5632 * 1024;
constexpr size_t W_MLAIN = 4 * W_FFN_SZ;
constexpr size_t W_QUP = W_MLAIN + (size_t)768 * 1024;
constexpr size_t W_KVUP = W_QUP + (size_t)1536 * 384;
constexpr size_t W_MLAO = W_KVUP + (size_t)2048 * 256;
constexpr size_t W_DILIN = W_MLAO + (size_t)1024 * 1024;
constexpr size_t W_DILO = W_DILIN + (size_t)9216 * 1024;
constexpr size_t W_END = W_DILO + (size_t)1024 * 1024;
static_assert(WS_WT + W_END * 2 <= WS_MOD, "weight copies fit");

constexpr int CW_BAR = 4096;
constexpr size_t CTL_ZERO_BYTES = 256 * 1024;
constexpr int LDS_BYTES = 147456;
constexpr int RING_BYTES = 131072;

__device__ __forceinline__ unsigned cvt_pk_bf16(float lo, float hi) { unsigned r; asm volatile("v_cvt_pk_bf16_f32 %0, %1, %2" : "=v"(r) : "v"(lo), "v"(hi)); return r; }
__device__ __forceinline__ float wave_sum(float v) {
#pragma unroll
    for (int o = 1; o < 64; o <<= 1) v += __shfl_xor(v, o);
    return v;
}
__device__ __forceinline__ float fast_silu(float g) { return g * __builtin_amdgcn_rcpf(1.0f + __builtin_amdgcn_exp2f(-g * LOG2E)); }

namespace pg8 {
constexpr int BM = 256, BK = 64, HALF = 128, HTB = HALF * BK * 2, STAGE_BYTES = 8 * HTB, NXCD = 8, WGM = 8;
__host__ __device__ __forceinline__ int lds_byte(int r, int c) { const int st = (r >> 4) * 2 + (c >> 5), rr = r & 15, cc = c & 31, ob = rr * 64 + cc * 2; return st * 1024 + (ob ^ (((ob >> 9) & 1) << 5)); }
__host__ __device__ __forceinline__ void stage_rc(int b, int& R, int& C) { const int st = b / 1024, sb = b % 1024, swz = sb ^ (((sb >> 9) & 1) << 5); R = (st >> 1) * 16 + swz / 64; C = (st & 1) * 32 + (swz % 64) / 2; }
__host__ __device__ __forceinline__ int perm32(int rho) { const int n = rho >> 4, i = rho & 15; return 8 * (i >> 2) + 4 * n + (i & 3); }

struct Unit { int pm, pn; };
struct Gemm { const bf16_t* A; const bf16_t* Bt; int M, N, K; };

struct StaticOrder {
    int nM, nN, nwg, G, c;
    __host__ __device__ void init(int M_, int N_, int G_, int c_) { nM = M_ / BM; nN = N_ / BM; nwg = nM * nN; G = G_; c = c_; }
    __host__ __device__ bool next(int i, Unit& u) const {
        const long L = (long)i * G + c; if (L >= nwg) return false;
        int wgid = (int)L; { const int q = nwg / NXCD, r = nwg % NXCD, xcd = wgid % NXCD, off = wgid / NXCD; wgid = (xcd < r ? xcd * (q + 1) : r * (q + 1) + (xcd - r) * q) + off; }
        const int nig = WGM * nN, gid = wgid / nig, fm = gid * WGM, gsz = (nM - fm) < WGM ? (nM - fm) : WGM;
        u.pm = fm + ((wgid % nig) % gsz); u.pn = (wgid % nig) / gsz; return true;
    }
    __device__ __forceinline__ void a_ready(const Unit&) const {}
    __device__ __forceinline__ void done(const Unit&) const {}
};

struct EpiF32 {
    static constexpr bool PERM = false, AFTER_DRAIN = false;
    float* C; int ldc;
    __device__ __forceinline__ void operator()(const f32x4 (&acc)[2][2][4][2], const Unit& u, int wr, int wc, int fr, int fq) const {
        const int row0 = u.pm * BM + wr * 64 + fr, col0 = u.pn * BM + wc * 32 + 4 * fq;
#pragma unroll
        for (int ai = 0; ai < 2; ++ai)
#pragma unroll
            for (int m = 0; m < 4; ++m) { float* rowp = C + (size_t)(row0 + ai * HALF + m * 16) * ldc + col0;
#pragma unroll
                for (int bj = 0; bj < 2; ++bj)
#pragma unroll
                    for (int n = 0; n < 2; ++n) *(f32x4*)(rowp + bj * HALF + n * 16) = acc[ai][bj][m][n]; }
    }
};
struct EpiBf16 {
    static constexpr bool PERM = true, AFTER_DRAIN = false;
    bf16_t* O; int ldc; int split_cols; size_t split_stride; float scale0;
    __device__ __forceinline__ void operator()(const f32x4 (&acc)[2][2][4][2], const Unit& u, int wr, int wc, int fr, int fq) const {
        const int row0 = u.pm * BM + wr * 64 + fr; int colt = u.pn * BM; bf16_t* base = O;
        float sc = 1.f; if (split_cols) { const int t = colt / split_cols; base += (size_t)t * split_stride; colt -= t * split_cols; if (t == 0) sc = scale0; }
        const int col0 = colt + wc * 32 + 8 * fq;
#pragma unroll
        for (int ai = 0; ai < 2; ++ai)
#pragma unroll
            for (int m = 0; m < 4; ++m) { bf16_t* rowp = base + (size_t)(row0 + ai * HALF + m * 16) * ldc + col0;
#pragma unroll
                for (int bj = 0; bj < 2; ++bj) { f32x4 v0 = acc[ai][bj][m][0] * sc, v1 = acc[ai][bj][m][1] * sc;
                    u32x4 w; w.x = cvt_pk_bf16(v0[0], v0[1]); w.y = cvt_pk_bf16(v0[2], v0[3]); w.z = cvt_pk_bf16(v1[0], v1[1]); w.w = cvt_pk_bf16(v1[2], v1[3]);
                    *(u32x4*)(rowp + bj * HALF) = w; } }
    }
};
struct EpiSwiGLU {
    static constexpr bool PERM = true, AFTER_DRAIN = false;
    bf16_t* O; int ldc;
    __device__ __forceinline__ void operator()(const f32x4 (&acc)[2][2][4][2], const Unit& u, int wr, int wc, int fr, int fq) const {
        const int row0 = u.pm * BM + wr * 64 + fr, col0 = u.pn * HALF + wc * 32 + 8 * fq;
#pragma unroll
        for (int ai = 0; ai < 2; ++ai)
#pragma unroll
            for (int m = 0; m < 4; ++m) { bf16_t* rowp = O + (size_t)(row0 + ai * HALF + m * 16) * ldc + col0;
                const f32x4 g0 = acc[ai][0][m][0], g1 = acc[ai][0][m][1], u0 = acc[ai][1][m][0], u1 = acc[ai][1][m][1];
                float v[8];
#pragma unroll
                for (int e = 0; e < 4; ++e) { v[e] = fast_silu(g0[e]) * u0[e]; v[4 + e] = fast_silu(g1[e]) * u1[e]; }
                u32x4 w; w.x = cvt_pk_bf16(v[0], v[1]); w.y = cvt_pk_bf16(v[2], v[3]); w.z = cvt_pk_bf16(v[4], v[5]); w.w = cvt_pk_bf16(v[6], v[7]);
                *(u32x4*)rowp = w; }
    }
};
struct EpiQ {
    static constexpr bool PERM = false, AFTER_DRAIN = false;
    bf16_t* O; const float* cosT; const float* sinT; float scale;
    __device__ __forceinline__ void operator()(const f32x4 (&acc)[2][2][4][2], const Unit& u, int wr, int wc, int fr, int fq) const {
        const int row0 = u.pm * BM + wr * 64 + fr;
        const int G0 = u.pn * 8 + wc, G1 = G0 + 4;
        const bool rope0 = (G0 % 3) == 2, rope1 = (G1 % 3) == 2;
#pragma unroll
        for (int ai = 0; ai < 2; ++ai)
#pragma unroll
            for (int m = 0; m < 4; ++m) {
                const int row = row0 + ai * HALF + m * 16;
                f32x4 c = (f32x4){1.f, 1.f, 1.f, 1.f}, s = (f32x4){0.f, 0.f, 0.f, 0.f};
                if (rope0 || rope1) { const int pos = row & (SEQ - 1); c = *(const f32x4*)(cosT + pos * 16 + 4 * fq); s = *(const f32x4*)(sinT + pos * 16 + 4 * fq); }
#pragma unroll
                for (int bj = 0; bj < 2; ++bj) {
                    const bool rope = bj ? rope1 : rope0;
                    f32x4 x1 = acc[ai][bj][m][0], x2 = acc[ai][bj][m][1];
                    if (rope) { const f32x4 o1 = x1 * c - x2 * s, o2 = x1 * s + x2 * c; x1 = o1; x2 = o2; }
                    x1 = x1 * scale; x2 = x2 * scale;
                    bf16_t* rowp = O + (size_t)row * 1536 + (bj ? G1 : G0) * 32 + 4 * fq;
                    u32x2 w1, w2; w1.x = cvt_pk_bf16(x1[0], x1[1]); w1.y = cvt_pk_bf16(x1[2], x1[3]); w2.x = cvt_pk_bf16(x2[0], x2[1]); w2.y = cvt_pk_bf16(x2[2], x2[3]);
                    *(u32x2*)rowp = w1; *(u32x2*)(rowp + 16) = w2; }
                asm volatile("" ::: "memory");
            }
    }
};

template <class Epi, class Sched, bool ALIGN_EPI = false, bool SP2 = false>
__device__ __forceinline__ void gemm_phase(int tid_in, LAS unsigned char* lds, const Gemm g, const Sched& S, const Epi& E) {
    const int tid = tid_in, wid = __builtin_amdgcn_readfirstlane(tid >> 6), lane = tid & 63, wr = wid >> 2, wc = wid & 3, fr = lane & 15, fq = lane >> 4;
    int K_ = g.K; asm volatile("" : "+s"(K_));
    const int K = K_, nt = K / BK;
    unsigned voffA[2], voffB[2];
#pragma unroll
    for (int i = 0; i < 2; ++i) { int R, C; stage_rc(tid * 16 + i * 8192, R, C); const int Rb = Epi::PERM ? ((R & ~31) + perm32(R & 31)) : R;
        voffA[i] = (unsigned)(R * K + C) * 2u; voffB[i] = (unsigned)(Rb * K + C) * 2u; }
    const size_t kstep = (size_t)(BK * 2);
    const size_t hstep = (size_t)HALF * K * 2;
    const size_t tstep = 2 * hstep;
    const unsigned ldsw = (unsigned)wid * 1024u;
    const int aoff = lds_byte(wr * 64 + fr, fq * 8), boff = lds_byte(wc * 32 + fr, fq * 8);
#define PG8_SA(b, h) (((b) * 2 + (h)) * HTB)
#define PG8_SB(b, h) ((4 + (b) * 2 + (h)) * HTB)
#define PG8_STAGE(bufoff, gbase, voff) do { _Pragma("unroll") for (int _i = 0; _i < 2; ++_i) \
        __builtin_amdgcn_global_load_lds((const unsigned*)((const char*)(gbase) + (voff)[_i]), (LAS unsigned*)(lds + (bufoff) + ldsw + _i * 8192), 16, 0, 0); } while (0)
#define PG8_LDA(dst, b, h) do { _Pragma("unroll") for (int m = 0; m < 4; ++m) _Pragma("unroll") for (int k = 0; k < 2; ++k) dst[m][k] = *(const LAS bf16x8*)(lds + PG8_SA(b, h) + aoff + m * 2048 + k * 1024); } while (0)
#define PG8_LDB(dst, b, h) do { _Pragma("unroll") for (int n = 0; n < 2; ++n) _Pragma("unroll") for (int k = 0; k < 2; ++k) dst[n][k] = *(const LAS bf16x8*)(lds + PG8_SB(b, h) + boff + n * 2048 + k * 1024); } while (0)
#define PG8_MMA(ai, bj, At, Bt) do { __builtin_amdgcn_s_setprio(1); _Pragma("unroll") for (int m = 0; m < 4; ++m) _Pragma("unroll") for (int n = 0; n < 2; ++n) _Pragma("unroll") for (int k = 0; k < 2; ++k) \
        acc[ai][bj][m][n] = __builtin_amdgcn_mfma_f32_16x16x32_bf16(Bt[n][k], At[m][k], acc[ai][bj][m][n], 0, 0, 0); __builtin_amdgcn_s_setprio(0); } while (0)
#define PG8_WAIT_V(n) asm volatile("s_waitcnt vmcnt(" #n ")" ::: "memory")
#define PG8_WAIT_L(n) asm volatile("s_waitcnt lgkmcnt(" #n ")" ::: "memory")
#define PG8_BAR __builtin_amdgcn_s_barrier()
#define PG8_SCHED __builtin_amdgcn_sched_barrier(0)
    Unit cur, nxt; int ui = 0;
    if (!S.next(0, cur)) return;
    f32x4 acc[2][2][4][2];
#pragma unroll
    for (int a = 0; a < 2; ++a)
#pragma unroll
        for (int b = 0; b < 2; ++b)
#pragma unroll
            for (int m = 0; m < 4; ++m)
#pragma unroll
                for (int n = 0; n < 2; ++n) acc[a][b][m][n] = (f32x4){0.f, 0.f, 0.f, 0.f};
    bf16x8 At[4][2], B0[2][2], B1[2][2];
    const char* cA = (const char*)g.A + (size_t)cur.pm * tstep; const char* cB = (const char*)g.Bt + (size_t)cur.pn * tstep;
    S.a_ready(cur);
    if constexpr (SP2) {
        PG8_STAGE(PG8_SB(0, 0), cB, voffB); PG8_STAGE(PG8_SB(0, 1), cB + hstep, voffB); PG8_STAGE(PG8_SA(0, 0), cA, voffA); PG8_STAGE(PG8_SA(0, 1), cA + hstep, voffA);
        if (wr == 1) PG8_BAR;
        PG8_WAIT_V(2); PG8_BAR;
        PG8_STAGE(PG8_SB(1, 0), cB + kstep, voffB); PG8_STAGE(PG8_SA(1, 0), cA + kstep, voffA); PG8_STAGE(PG8_SB(1, 1), cB + hstep + kstep, voffB);
        PG8_WAIT_V(6); PG8_BAR;
    } else {
        PG8_STAGE(PG8_SB(0, 0), cB, voffB); PG8_STAGE(PG8_SA(0, 0), cA, voffA); PG8_STAGE(PG8_SB(0, 1), cB + hstep, voffB); PG8_STAGE(PG8_SA(0, 1), cA + hstep, voffA);
        if (wr == 1) PG8_BAR;
        PG8_WAIT_V(4); PG8_BAR;
        PG8_STAGE(PG8_SB(1, 0), cB + kstep, voffB); PG8_STAGE(PG8_SA(1, 0), cA + kstep, voffA); PG8_STAGE(PG8_SB(1, 1), cB + hstep + kstep, voffB);
        PG8_WAIT_V(6); PG8_BAR;
    }
    for (;;) {
        const bool has_next = S.next(ui + 1, nxt);
        const char* nA = has_next ? (const char*)g.A + (size_t)nxt.pm * tstep : cA; const char* nB = has_next ? (const char*)g.Bt + (size_t)nxt.pn * tstep : cB;
        for (int t = 0; t < nt; t += 2) {
            const bool last = (t == nt - 2);
            const char* a1 = cA + (size_t)(t + 1) * kstep;
            const char* a2 = last ? nA : cA + (size_t)(t + 2) * kstep; const char* b2 = last ? nB : cB + (size_t)(t + 2) * kstep;
            const char* a3 = a2 + kstep; const char* b3 = b2 + kstep;
            if (last && has_next) S.a_ready(nxt);
            if constexpr (SP2) {
            PG8_LDB(B0, 0, 0); PG8_LDB(B1, 0, 1); PG8_SCHED; PG8_LDA(At, 0, 0); PG8_STAGE(PG8_SA(1, 1), a1 + hstep, voffA);
            PG8_WAIT_V(8); PG8_WAIT_L(0); PG8_BAR; PG8_MMA(0, 0, At, B0); PG8_MMA(0, 1, At, B1); PG8_BAR; PG8_SCHED;
            PG8_LDA(At, 0, 1); PG8_STAGE(PG8_SB(0, 0), b2, voffB); PG8_STAGE(PG8_SB(0, 1), b2 + hstep, voffB); PG8_STAGE(PG8_SA(0, 0), a2, voffA);
            PG8_WAIT_V(8); PG8_WAIT_L(0); PG8_BAR; PG8_MMA(1, 0, At, B0); PG8_MMA(1, 1, At, B1); PG8_BAR; PG8_SCHED;
            PG8_LDB(B0, 1, 0); PG8_LDB(B1, 1, 1); PG8_SCHED; PG8_LDA(At, 1, 0); PG8_STAGE(PG8_SA(0, 1), a2 + hstep, voffA);
            PG8_WAIT_V(8); PG8_WAIT_L(0); PG8_BAR; PG8_MMA(0, 0, At, B0); PG8_MMA(0, 1, At, B1); PG8_BAR; PG8_SCHED;
            PG8_LDA(At, 1, 1); PG8_STAGE(PG8_SB(1, 0), b3, voffB); PG8_STAGE(PG8_SB(1, 1), b3 + hstep, voffB); PG8_STAGE(PG8_SA(1, 0), a3, voffA);
            PG8_WAIT_V(8); PG8_WAIT_L(0); PG8_BAR; PG8_MMA(1, 0, At, B0); PG8_MMA(1, 1, At, B1); PG8_BAR; PG8_SCHED;
            } else {
            PG8_LDB(B0, 0, 0); PG8_SCHED; PG8_LDA(At, 0, 0); PG8_STAGE(PG8_SA(1, 1), a1 + hstep, voffA);
            PG8_WAIT_L(8); PG8_BAR; PG8_WAIT_L(0); PG8_MMA(0, 0, At, B0); PG8_BAR; PG8_SCHED;
            PG8_LDB(B1, 0, 1); PG8_STAGE(PG8_SB(0, 0), b2, voffB);
            PG8_BAR; PG8_WAIT_L(0); PG8_MMA(0, 1, At, B1); PG8_BAR;
            PG8_LDA(At, 0, 1); PG8_STAGE(PG8_SA(0, 0), a2, voffA);
            PG8_BAR; PG8_WAIT_L(0); PG8_MMA(1, 0, At, B0); PG8_BAR; PG8_SCHED;
            PG8_STAGE(PG8_SB(0, 1), b2 + hstep, voffB);
            PG8_WAIT_V(6); PG8_BAR; PG8_MMA(1, 1, At, B1); PG8_BAR;
            PG8_LDB(B0, 1, 0); PG8_SCHED; PG8_LDA(At, 1, 0); PG8_STAGE(PG8_SA(0, 1), a2 + hstep, voffA);
            PG8_WAIT_L(8); PG8_BAR; PG8_WAIT_L(0); PG8_MMA(0, 0, At, B0); PG8_BAR; PG8_SCHED;
            PG8_LDB(B1, 1, 1); PG8_STAGE(PG8_SB(1, 0), b3, voffB);
            PG8_BAR; PG8_WAIT_L(0); PG8_MMA(0, 1, At, B1); PG8_BAR;
            PG8_LDA(At, 1, 1); PG8_STAGE(PG8_SA(1, 0), a3, voffA);
            PG8_BAR; PG8_WAIT_L(0); PG8_MMA(1, 0, At, B0); PG8_BAR; PG8_SCHED;
            PG8_STAGE(PG8_SB(1, 1), b3 + hstep, voffB);
            PG8_WAIT_V(6); PG8_BAR; PG8_MMA(1, 1, At, B1); PG8_BAR;
            }
        }
        if constexpr (ALIGN_EPI) { if (wr == 0) PG8_BAR; }
        if constexpr (!Epi::AFTER_DRAIN) { E(acc, cur, wr, wc, fr, fq); S.done(cur); }
        if (!has_next) break;
#pragma unroll
        for (int a = 0; a < 2; ++a)
#pragma unroll
            for (int b = 0; b < 2; ++b)
#pragma unroll
                for (int m = 0; m < 4; ++m)
#pragma unroll
                    for (int n = 0; n < 2; ++n) acc[a][b][m][n] = (f32x4){0.f, 0.f, 0.f, 0.f};
        cur = nxt; cA = nA; cB = nB; ++ui;
        if constexpr (ALIGN_EPI) { if (wr == 1) PG8_BAR; }
    }
    PG8_WAIT_V(0);
    if constexpr (!ALIGN_EPI) { if (wr == 0) PG8_BAR; }
    PG8_BAR;
#undef PG8_SA
#undef PG8_SB
#undef PG8_STAGE
#undef PG8_LDA
#undef PG8_LDB
#undef PG8_MMA
#undef PG8_WAIT_V
#undef PG8_WAIT_L
#undef PG8_BAR
#undef PG8_SCHED
}
}

struct Params { const float* in[18]; float* out; unsigned char* ws; int ph_lo, ph_hi; };
enum { I_X = 0, I_C, I_NPRE, I_NPOST, I_WMOD, I_BMOD, I_WG, I_WU, I_WD, I_MIN, I_MQN, I_MQUP, I_MKVN, I_MKVUP, I_MWO, I_DIN, I_DWO, I_RB };

__device__ __forceinline__ unsigned f2bf(float f) { unsigned u = __builtin_bit_cast(unsigned, f); return (u + 0x7fffu + ((u >> 16) & 1u)) >> 16; }
__device__ __forceinline__ unsigned pk2(float lo, float hi) { return f2bf(lo) | (f2bf(hi) << 16); }

__device__ __forceinline__ void p0_transpose_item(const float* W, int K, int N, bf16_t* WT, int k0, int n0, int drow0, LAS float* scr, int lane) {
#pragma unroll 8
    for (int i = 0; i < 32; ++i) { const int kk = 2 * i + (lane >> 5); scr[kk * 33 + (lane & 31)] = W[(size_t)(k0 + kk) * N + n0 + (lane & 31)]; }
    asm volatile("s_waitcnt lgkmcnt(0)" ::: "memory");
    const int c = lane & 7;
#pragma unroll
    for (int j = 0; j < 4; ++j) { const int n = (lane >> 3) + 8 * j; const LAS float* s = scr + (8 * c) * 33 + n;
        u32x4 o; o.x = pk2(s[0 * 33], s[1 * 33]); o.y = pk2(s[2 * 33], s[3 * 33]); o.z = pk2(s[4 * 33], s[5 * 33]); o.w = pk2(s[6 * 33], s[7 * 33]);
        *(u32x4*)(WT + (size_t)(drow0 + n) * K + k0 + 8 * c) = o; }
    asm volatile("s_waitcnt lgkmcnt(0)" ::: "memory");
}
__device__ __forceinline__ int tr_drow(int kind, int n0) {
    if (kind == 1) return (n0 >> 7) * 256 + (n0 & 127);
    if (kind == 2) return (n0 >> 7) * 256 + 128 + (n0 & 127);
    if (kind == 3) { const int h = n0 >> 7, w = n0 & 127; return (w < 64) ? h * 64 + w : 1024 + h * 64 + (w - 64); }
    return n0;
}
__device__ __forceinline__ void sincos_f(float a, float& s, float& c) {
    const float k = __builtin_rintf(a * 0.15915494309189535f);
    float x = __builtin_fmaf(-k, 6.2831854820251465f, a); x = __builtin_fmaf(-k, -1.7484555e-07f, x);
    const float x2 = x * x;
    float ts = x, tc = 1.0f; s = x; c = 1.0f;
#pragma unroll 1
    for (int i = 1; i <= 13; ++i) { tc = -tc * x2 / (float)((2 * i - 1) * (2 * i)); ts = -ts * x2 / (float)((2 * i) * (2 * i + 1)); c += tc; s += ts; }
}
__device__ __forceinline__ void p0_prologue(int tid_in, const Params& P, LAS unsigned char* lds, int vcu, int G) {
    const int tid = tid_in, lane = tid & 63, wave = __builtin_amdgcn_readfirstlane(tid >> 6);
    unsigned char* ws = P.ws;
    {
        const int gt = vcu * 512 + tid, NT = G * 512;
        float* cosT = (float*)(ws + WS_COS); float* sinT = (float*)(ws + WS_SIN);
        for (int e = gt; e < SEQ * 16; e += NT) { const int pos = e >> 4, i = e & 15;
            const int iq = i >> 2, ir = i & 3;
            const float fb = (iq == 0) ? 1.0f : (iq == 1) ? 0.1f : (iq == 2) ? 0.01f : 0.001f;
            const float fm = (ir == 0) ? 1.0f : (ir == 1) ? 0.5623413251903491f : (ir == 2) ? 0.31622776601683794f : 0.1778279410038923f;
            float sn, cs; sincos_f((float)pos * (fb * fm), sn, cs); cosT[e] = cs; sinT[e] = sn; }
        float* bT = (float*)(ws + WS_BIAS); const float* rb = P.in[I_RB];
        for (int e = gt; e < 3 * 16 * 192; e += NT) { const int g = e / (16 * 192), h = (e / 192) % 16, rel = (e % 192) - 32; const int dil = (g == 0) ? 1 : (g == 1) ? 4 : 16;
            float v = -INFINITY;
            if (rel >= 0 && rel <= 128) { const int dist = rel * dil; int bucket;
                if (dist < 16) bucket = dist; else { const float dd = (float)dist; int lg = 16 + (int)(__builtin_logf(dd / 16.0f) / __builtin_logf(128.0f) * 16.0f); bucket = lg < 31 ? lg : 31; }
                v = rb[bucket * 48 + g * 16 + h] * LOG2E; }
            bT[e] = v; }
    }
    {
        LAS float* sc = (LAS float*)lds;
        LAS float* red = (LAS float*)(lds + 32768);
        const float* c = P.in[I_C];
        for (int e = tid; e < 8 * 1024; e += 512) { const int b = e >> 10, k = e & 1023; const float v = c[e]; sc[k * 8 + b] = v / (1.0f + __expf(-v)); }
        __syncthreads();
        float* mod = (float*)(ws + WS_MOD);
        for (int it = vcu; it < 288; it += G) {
            const int l = it / 144, n0 = (it % 144) * 64;
            const float* W = P.in[I_WMOD] + (size_t)l * 1024 * 9216 + n0 + lane;
            float a[8];
#pragma unroll
            for (int b = 0; b < 8; ++b) a[b] = 0.f;
            const int k0 = wave * 128;
#pragma unroll 4
            for (int k = 0; k < 128; ++k) { const float w = W[(size_t)(k0 + k) * 9216];
                const f32x4 s0 = *(const LAS f32x4*)(sc + (k0 + k) * 8), s1 = *(const LAS f32x4*)(sc + (k0 + k) * 8 + 4);
                a[0] += s0[0] * w; a[1] += s0[1] * w; a[2] += s0[2] * w; a[3] += s0[3] * w; a[4] += s1[0] * w; a[5] += s1[1] * w; a[6] += s1[2] * w; a[7] += s1[3] * w; }
#pragma unroll
            for (int b = 0; b < 8; ++b) red[(wave * 8 + b) * 64 + lane] = a[b];
            __syncthreads();
            { const int b = tid >> 6; float s = 0.f;
#pragma unroll
              for (int w = 0; w < 8; ++w) s += red[(w * 8 + b) * 64 + lane];
              mod[(size_t)l * 8 * 9216 + (size_t)b * 9216 + n0 + lane] = s + P.in[I_BMOD][l * 9216 + n0 + lane]; }
            __syncthreads();
        }
    }
    __syncthreads();
    {
        LAS float* scr = (LAS float*)(lds + wave * 16384);
        bf16_t* WT = (bf16_t*)(ws + WS_WT);
        const int gw = vcu * 8 + wave, NGW = G * 8;
        constexpr int I_FFN = 1408, I_ALLFFN = 12 * I_FFN, I1 = 336, I2 = 288, I3 = 256, I4 = 512, I5 = 4608, I6 = 512;
        constexpr int NITEMS = I_ALLFFN + I1 + I2 + I3 + I4 + I5 + I6;
        for (int it = gw; it < NITEMS; it += NGW) {
            const float* src; bf16_t* dst; int K, N, kind = 0, r = it;
            if (r < I_ALLFFN) { const int mtx = r / I_FFN; r -= mtx * I_FFN; const int ffn = mtx / 3, which = mtx % 3;
                if (which == 0) { src = P.in[I_WG] + (size_t)ffn * 1024 * FF; K = 1024; N = FF; kind = 1; dst = WT + ffn * W_FFN_SZ + W_GU0; }
                else if (which == 1) { src = P.in[I_WU] + (size_t)ffn * 1024 * FF; K = 1024; N = FF; kind = 2; dst = WT + ffn * W_FFN_SZ + W_GU0; }
                else { src = P.in[I_WD] + (size_t)ffn * FF * 1024; K = FF; N = 1024; dst = WT + ffn * W_FFN_SZ + W_DN0; } }
            else { r -= I_ALLFFN;
                if (r < I1) { src = P.in[I_MIN]; K = 1024; N = 672; dst = WT + W_MLAIN; }
                else if ((r -= I1) < I2) { src = P.in[I_MQUP]; K = 384; N = 1536; dst = WT + W_QUP; }
                else if ((r -= I2) < I3) { src = P.in[I_MKVUP]; K = 256; N = 2048; kind = 3; dst = WT + W_KVUP; }
                else if ((r -= I3) < I4) { src = P.in[I_MWO]; K = 1024; N = 1024; dst = WT + W_MLAO; }
                else if ((r -= I4) < I5) { src = P.in[I_DIN]; K = 1024; N = 9216; dst = WT + W_DILIN; }
                else { r -= I5; src = P.in[I_DWO]; K = 1024; N = 1024; dst = WT + W_DILO; } }
            const int nblk = N / 32, kb = r / nblk, nb = r % nblk;
            p0_transpose_item(src, K, N, dst, kb * 64, nb * 32, tr_drow(kind, nb * 32), scr, lane);
        }
        { const int gt = vcu * 512 + tid, NT = G * 512; u32x4* z = (u32x4*)(WT + W_MLAIN + (size_t)672 * 1024);
          for (int e = gt; e < 96 * 1024 / 8; e += NT) z[e] = (u32x4){0u, 0u, 0u, 0u}; }
    }
}

__device__ __forceinline__ void norm_phase(int tid_in, const Params& P, int k, int vcu, int G) {
    const int tid = tid_in, lane = tid & 63, wave = __builtin_amdgcn_readfirstlane(tid >> 6);
    const int gw = vcu * 8 + wave, NGW = G * 8;
    const float* mod = (const float*)(P.ws + WS_MOD);
    const float* Y = (const float*)(P.ws + WS_Y);
    bf16_t* HN = (bf16_t*)(P.ws + WS_HN);
    const float* xin = (k <= 1) ? P.in[I_X] : P.out;
    const bool upd = (k >= 1), pre = (k <= 5);
    const int su = k - 1, lu = su / 3, subu = su % 3;
    const int lp = k / 3, subp = k % 3;
    const float rw = (subu == 1) ? 1.0f : 0.5f;
    for (int row = gw; row < M; row += NGW) {
        const int b = row >> 11;
        f32x4 x[4];
#pragma unroll
        for (int j = 0; j < 4; ++j) x[j] = *((const f32x4*)(xin + (size_t)row * D) + lane + 64 * j);
        if (upd) {
            f32x4 y[4]; float ss = 0.f;
#pragma unroll
            for (int j = 0; j < 4; ++j) { y[j] = *((const f32x4*)(Y + (size_t)row * D) + lane + 64 * j); ss += (y[j][0] * y[j][0] + y[j][1] * y[j][1]) + (y[j][2] * y[j][2] + y[j][3] * y[j][3]); }
            const float rstd = 1.0f / sqrtf(wave_sum(ss) * (1.0f / D) + EPS);
            const float* gate = mod + (size_t)lu * 8 * 9216 + (size_t)b * 9216 + subu * 3072 + 2048;
            const float* post = P.in[I_NPOST] + (lu * 3 + subu) * D;
#pragma unroll
            for (int j = 0; j < 4; ++j) { const f32x4 g = *((const f32x4*)gate + lane + 64 * j), pg = *((const f32x4*)post + lane + 64 * j);
                x[j] = x[j] + (g * rw) * ((y[j] * rstd) * pg);
                *((f32x4*)(P.out + (size_t)row * D) + lane + 64 * j) = x[j]; }
        }
        if (pre) {
            float ss = 0.f;
#pragma unroll
            for (int j = 0; j < 4; ++j) ss += (x[j][0] * x[j][0] + x[j][1] * x[j][1]) + (x[j][2] * x[j][2] + x[j][3] * x[j][3]);
            const float rstd = 1.0f / sqrtf(wave_sum(ss) * (1.0f / D) + EPS);
            const float* shift = mod + (size_t)lp * 8 * 9216 + (size_t)b * 9216 + subp * 3072;
            const float* scale = shift + 1024;
            const float* pg_ = P.in[I_NPRE] + (lp * 3 + subp) * D;
#pragma unroll
            for (int j = 0; j < 4; ++j) { const f32x4 sh = *((const f32x4*)shift + lane + 64 * j), scl = *((const f32x4*)scale + lane + 64 * j), pg = *((const f32x4*)pg_ + lane + 64 * j);
                const f32x4 h = ((x[j] * rstd) * pg) * (scl + 1.0f) + sh;
                u32x2 w; w.x = cvt_pk_bf16(h[0], h[1]); w.y = cvt_pk_bf16(h[2], h[3]);
                *((u32x2*)(HN + (size_t)row * D) + lane + 64 * j) = w; }
        }
    }
}

__device__ __forceinline__ void mla_row_phase(int tid_in, const Params& P, int vcu, int G) {
    const int tid = tid_in, lane = tid & 63, wave = __builtin_amdgcn_readfirstlane(tid >> 6);
    const int gw = vcu * 8 + wave, NGW = G * 8;
    const float* LAT = (const float*)(P.ws + WS_LAT);
    bf16_t* CQN = (bf16_t*)(P.ws + WS_CQN); bf16_t* CKVN = (bf16_t*)(P.ws + WS_CKVN); bf16_t* KR = (bf16_t*)(P.ws + WS_KR);
    const float* cosT = (const float*)(P.ws + WS_COS); const float* sinT = (const float*)(P.ws + WS_SIN);
    const float* qn = P.in[I_MQN]; const float* kvn = P.in[I_MKVN];
    for (int row = gw; row < M; row += NGW) {
        const float* lr = LAT + (size_t)row * 768;
        const f32x4 a = *((const f32x4*)lr + lane); const f32x2 a2 = *((const f32x2*)(lr + 256) + lane);
        const f32x4 kv = *((const f32x4*)(lr + 384) + lane);
        float x1 = 0.f, x2 = 0.f; if (lane < 16) { x1 = lr[640 + lane]; x2 = lr[656 + lane]; }
        float ssq = (a[0] * a[0] + a[1] * a[1]) + (a[2] * a[2] + a[3] * a[3]) + (a2[0] * a2[0] + a2[1] * a2[1]);
        float ssk = (kv[0] * kv[0] + kv[1] * kv[1]) + (kv[2] * kv[2] + kv[3] * kv[3]);
        const float rq = 1.0f / sqrtf(wave_sum(ssq) * (1.0f / 384.0f) + EPS), rk = 1.0f / sqrtf(wave_sum(ssk) * (1.0f / 256.0f) + EPS);
        const f32x4 g = *((const f32x4*)qn + lane); const f32x2 g2 = *((const f32x2*)(qn + 256) + lane); const f32x4 gk = *((const f32x4*)kvn + lane);
        u32x2 w; w.x = cvt_pk_bf16(a[0] * rq * g[0], a[1] * rq * g[1]); w.y = cvt_pk_bf16(a[2] * rq * g[2], a[3] * rq * g[3]);
        *((u32x2*)(CQN + (size_t)row * 384) + lane) = w;
        *((unsigned*)(CQN + (size_t)row * 384 + 256) + lane) = cvt_pk_bf16(a2[0] * rq * g2[0], a2[1] * rq * g2[1]);
        u32x2 wk; wk.x = cvt_pk_bf16(kv[0] * rk * gk[0], kv[1] * rk * gk[1]); wk.y = cvt_pk_bf16(kv[2] * rk * gk[2], kv[3] * rk * gk[3]);
        *((u32x2*)(CKVN + (size_t)row * 256) + lane) = wk;
        if (lane < 16) { const int pos = row & (SEQ - 1); const float c = cosT[pos * 16 + lane], s = sinT[pos * 16 + lane];
            KR[(size_t)row * 32 + lane] = (bf16_t)f2bf(x1 * c - x2 * s); KR[(size_t)row * 32 + 16 + lane] = (bf16_t)f2bf(x1 * s + x2 * c); }
    }
}

__device__ __forceinline__ int crow(int r, int hi) { return (r & 3) + 8 * (r >> 2) + 4 * hi; }
typedef short v4i16_t __attribute__((ext_vector_type(4)));
__device__ __forceinline__ s16x4 vtr(const LAS unsigned char* p) { return __builtin_bit_cast(s16x4, __builtin_amdgcn_ds_read_tr16_b64_v4i16((LAS v4i16_t*)p)); }
#define MFMA32(a, b, c) __builtin_amdgcn_mfma_f32_32x32x16_bf16((a), (b), (c), 0, 0, 0)

template <bool TWO> __device__ __forceinline__ void softmax_update(f32x16& p0, f32x16& p1, float& m, float& l, f32x16& o0, f32x16& o1) {
    float mx = p0[0];
#pragma unroll
    for (int r = 1; r < 16; ++r) mx = fmaxf(mx, p0[r]);
    if (TWO) {
#pragma unroll
        for (int r = 0; r < 16; ++r) mx = fmaxf(mx, p1[r]); }
    mx = fmaxf(mx, __shfl_xor(mx, 32));
    const float mn = fmaxf(m, mx);
    const float alpha = __builtin_amdgcn_exp2f(m - mn);
    m = mn;
    float s = 0.f;
#pragma unroll
    for (int r = 0; r < 16; ++r) { p0[r] = __builtin_amdgcn_exp2f(p0[r] - mn); s += p0[r]; }
    if (TWO) {
#pragma unroll
        for (int r = 0; r < 16; ++r) { p1[r] = __builtin_amdgcn_exp2f(p1[r] - mn); s += p1[r]; } }
    l = l * alpha + s;
#pragma unroll
    for (int r = 0; r < 16; ++r) { o0[r] *= alpha; o1[r] *= alpha; }
}
__device__ __forceinline__ bf16x8 pack8(const f32x16& p, int b) {
    u32x4 w; w.x = cvt_pk_bf16(p[b], p[b + 1]); w.y = cvt_pk_bf16(p[b + 2], p[b + 3]); w.z = cvt_pk_bf16(p[b + 4], p[b + 5]); w.w = cvt_pk_bf16(p[b + 6], p[b + 7]);
    return __builtin_bit_cast(bf16x8, w);
}
__device__ __forceinline__ bf16x8 vfrag(const LAS unsigned char* p) { const s16x4 lo = vtr(p), hi = vtr(p + 512); return (bf16x8){lo[0], lo[1], lo[2], lo[3], hi[0], hi[1], hi[2], hi[3]}; }

constexpr int MA_KROW = 208, MA_KB = 64 * MA_KROW  , MA_VB = 8192, MA_K0 = 0, MA_V0 = 2 * MA_KB, MA_ST = MA_V0 + 2 * MA_VB  , MA_STW = 32 * 144;
__device__ __forceinline__ void mla_attn_phase(int tid_in, const Params& P, LAS unsigned char* lds, int vcu) {
    const int tid = tid_in, lane = tid & 63, wid = __builtin_amdgcn_readfirstlane(tid >> 6), r32 = lane & 31, hi = lane >> 5;
    const bf16_t* Q = (const bf16_t*)(P.ws + WS_Q); const bf16_t* KN = (const bf16_t*)(P.ws + WS_KN); const bf16_t* KR = (const bf16_t*)(P.ws + WS_KR);
    const bf16_t* V = (const bf16_t*)(P.ws + WS_V); bf16_t* O = (bf16_t*)(P.ws + WS_HN);
    const int bh = vcu >> 1, sg = vcu & 1, b = bh >> 4, h = bh & 15;
    const size_t rowbase = (size_t)b * SEQ;
    const int krow = tid >> 3, kch = tid & 7, rrow = tid >> 2, rch = tid & 3;
    const unsigned kwoff = krow * MA_KROW + kch * 16, rwoff = rrow * MA_KROW + 128 + rch * 16;
    const unsigned vwoff = (kch >> 2) * 4096 + (krow >> 4) * 1024 + (krow & 15) * 64 + (kch & 3) * 16;
    const unsigned vrd = ((lane >> 4) & 1) * 32 + (lane & 3) * 8 + (4 * hi + ((lane & 15) >> 2)) * 64;
    for (int ui = 0; ui < 4; ++ui) {
        const int qb = (ui == 0) ? sg : (ui == 1) ? 7 - sg : (ui == 2) ? 2 + sg : 5 - sg;
        const int q0w = qb * 256 + wid * 32, qabs = q0w + r32;
        const int NT = 4 * (qb + 1);
        bf16x8 qf[6];
        { const bf16_t* qp = Q + (rowbase + qabs) * 1536 + h * 96 + hi * 8;
#pragma unroll
          for (int s = 0; s < 6; ++s) qf[s] = *(const bf16x8*)(qp + s * 16); }
        u32x4 gk, gr = (u32x4){0u, 0u, 0u, 0u}, gv;
        { const size_t r0 = rowbase;
          gk = *(const u32x4*)(KN + (r0 + krow) * 1024 + h * 64 + kch * 8); gv = *(const u32x4*)(V + (r0 + krow) * 1024 + h * 64 + kch * 8);
          if (tid < 256) gr = *(const u32x4*)(KR + (r0 + rrow) * 32 + rch * 8); }
        *(LAS u32x4*)(lds + MA_K0 + kwoff) = gk; *(LAS u32x4*)(lds + MA_V0 + vwoff) = gv; if (tid < 256) *(LAS u32x4*)(lds + MA_K0 + rwoff) = gr;
        __syncthreads();
        float m = -INFINITY, l = 0.f; f32x16 o0 = {}, o1 = {};
        for (int t = 0; t < NT; ++t) {
            const int cur = t & 1, kv0 = t * 64;
            if (t + 1 < NT) { const size_t r0 = rowbase + (size_t)(t + 1) * 64;
                gk = *(const u32x4*)(KN + (r0 + krow) * 1024 + h * 64 + kch * 8); gv = *(const u32x4*)(V + (r0 + krow) * 1024 + h * 64 + kch * 8);
                if (tid < 256) gr = *(const u32x4*)(KR + (r0 + rrow) * 32 + rch * 8); }
            if (kv0 <= q0w + 31) {
                const LAS unsigned char* kb = lds + MA_K0 + cur * MA_KB + r32 * MA_KROW + hi * 16;
                const LAS unsigned char* vb = lds + MA_V0 + cur * MA_VB + vrd;
                f32x16 p0 = {}, p1 = {};
#pragma unroll
                for (int s = 0; s < 6; ++s) { const bf16x8 a0 = *(const LAS bf16x8*)(kb + s * 32), a1 = *(const LAS bf16x8*)(kb + 32 * MA_KROW + s * 32);
                    p0 = MFMA32(a0, qf[s], p0); p1 = MFMA32(a1, qf[s], p1); }
                if (kv0 + 63 > q0w) {
#pragma unroll
                    for (int r = 0; r < 16; ++r) { const int ka = kv0 + crow(r, hi); if (ka > qabs) p0[r] = -INFINITY; if (ka + 32 > qabs) p1[r] = -INFINITY; } }
                softmax_update<true>(p0, p1, m, l, o0, o1);
                const bf16x8 pf0 = pack8(p0, 0), pf1 = pack8(p0, 8), pf2 = pack8(p1, 0), pf3 = pack8(p1, 8);
                o0 = MFMA32(vfrag(vb + 0 * 1024), pf0, o0); o0 = MFMA32(vfrag(vb + 1 * 1024), pf1, o0); o0 = MFMA32(vfrag(vb + 2 * 1024), pf2, o0); o0 = MFMA32(vfrag(vb + 3 * 1024), pf3, o0);
                o1 = MFMA32(vfrag(vb + 4096 + 0 * 1024), pf0, o1); o1 = MFMA32(vfrag(vb + 4096 + 1 * 1024), pf1, o1); o1 = MFMA32(vfrag(vb + 4096 + 2 * 1024), pf2, o1); o1 = MFMA32(vfrag(vb + 4096 + 3 * 1024), pf3, o1);
            }
            if (t + 1 < NT) { const int nx = cur ^ 1;
                *(LAS u32x4*)(lds + MA_K0 + nx * MA_KB + kwoff) = gk; *(LAS u32x4*)(lds + MA_V0 + nx * MA_VB + vwoff) = gv; if (tid < 256) *(LAS u32x4*)(lds + MA_K0 + nx * MA_KB + rwoff) = gr; }
            __syncthreads();
        }
        l += __shfl_xor(l, 32);
        const float rl = 1.0f / l;
        LAS unsigned char* st = lds + MA_ST + wid * MA_STW;
#pragma unroll
        for (int r = 0; r < 16; ++r) { const int d = crow(r, hi);
            *(LAS bf16_t*)(st + r32 * 144 + d * 2) = (bf16_t)f2bf(o0[r] * rl); *(LAS bf16_t*)(st + r32 * 144 + (32 + d) * 2) = (bf16_t)f2bf(o1[r] * rl); }
        asm volatile("s_waitcnt lgkmcnt(0)" ::: "memory");
#pragma unroll
        for (int i = 0; i < 4; ++i) { const int row = i * 8 + (lane >> 3), ch = lane & 7; const u32x4 v = *(const LAS u32x4*)(st + row * 144 + ch * 16);
            *(u32x4*)(O + (rowbase + q0w + row) * 1024 + h * 64 + ch * 8) = v; }
        __syncthreads();
    }
}

constexpr int DA_WB = 8704;
constexpr int DA_TAB = 8 * DA_WB;
__device__ __forceinline__ void dil_attn_phase(int tid_in, const Params& P, LAS unsigned char* lds, int g, int vcu, int G) {
    const int tid = tid_in, lane = tid & 63, wid = __builtin_amdgcn_readfirstlane(tid >> 6), r32 = lane & 31, hi = lane >> 5;
    const bf16_t* PR = (const bf16_t*)(P.ws + WS_PROJ);
    float* SO = (float*)(P.ws + WS_SO); float* SM = (float*)(P.ws + WS_SM); float* SL = (float*)(P.ws + WS_SL);
    bf16_t* O = (bf16_t*)(P.ws + WS_HN);
    const int lr = (g == 0) ? 0 : (g == 1) ? 2 : 4, r = 1 << lr;
    const int nms = (SEQ >> lr) >> 5;
    { const float* bT = (const float*)(P.ws + WS_BIAS) + g * 16 * 192; LAS float* tab = (LAS float*)(lds + DA_TAB);
      for (int e = tid; e < 16 * 192; e += 512) tab[e] = bT[e]; }
    __syncthreads();
    LAS unsigned char* wl = lds + wid * DA_WB;
    LAS unsigned char* kl = wl; LAS unsigned char* vl = wl + 4608;
    const int lrow = lane >> 3, lch = lane & 7;
    const unsigned vrd = ((lane >> 4) & 1) * 32 + (lane & 3) * 8 + (4 * hi + ((lane & 15) >> 2)) * 64;
    const int gw = vcu * 8 + wid, NGW = G * 8;
    for (int s = gw; s < 8192; s += NGW) {
        const int ms = s % nms; int t_ = s / nms; const int rho = t_ % r; t_ /= r; const int h = t_ & 15, b = t_ >> 4;
        const int m0 = ms * 32;
        const size_t rowb = (size_t)b * SEQ;
        const size_t qrow = rowb + (size_t)r * (m0 + r32) + rho;
        bf16x8 qf[4];
#pragma unroll
        for (int s4 = 0; s4 < 4; ++s4) qf[s4] = *(const bf16x8*)(PR + qrow * 3072 + h * 64 + s4 * 16 + hi * 8);
        float m = -INFINITY, l = 0.f; f32x16 o0 = {}, o1 = {};
        if (g > 0) {
#pragma unroll
            for (int j = 0; j < 8; ++j) { const int q = (lane >> 4) + 4 * j, c4 = lane & 15; const size_t tr = rowb + (size_t)r * (m0 + q) + rho;
                *(LAS f32x4*)(wl + (q * 68 + c4 * 4) * 4) = *(const f32x4*)(SO + tr * 1024 + h * 64 + c4 * 4); }
#pragma unroll
            for (int rr = 0; rr < 16; ++rr) { const int d = crow(rr, hi); o0[rr] = *(const LAS float*)(wl + (r32 * 68 + d) * 4); o1[rr] = *(const LAS float*)(wl + (r32 * 68 + 32 + d) * 4); }
            m = SM[qrow * 16 + h]; l = hi ? 0.f : SL[qrow * 16 + h];
        }
        const int i0 = (m0 >= 128) ? 0 : ((128 - m0) >> 5);
        u32x4 gk[4], gv[4];
        { const int kt0 = m0 - 128 + 32 * i0;
#pragma unroll
          for (int j = 0; j < 4; ++j) { const size_t kr_ = rowb + (size_t)r * (kt0 + lrow + 8 * j) + rho;
              gk[j] = *(const u32x4*)(PR + kr_ * 3072 + 1024 + h * 64 + lch * 8); gv[j] = *(const u32x4*)(PR + kr_ * 3072 + 2048 + h * 64 + lch * 8); } }
        const LAS float* tabh = (const LAS float*)(lds + DA_TAB) + h * 192;
        for (int i = i0; i < 5; ++i) {
#pragma unroll
            for (int j = 0; j < 4; ++j) { const int k = lrow + 8 * j;
                *(LAS u32x4*)(kl + k * 144 + lch * 16) = gk[j];
                *(LAS u32x4*)(vl + (lch >> 2) * 2048 + (k >> 4) * 1024 + (k & 15) * 64 + (lch & 3) * 16) = gv[j]; }
            if (i + 1 < 5) { const int kt0 = m0 - 128 + 32 * (i + 1);
#pragma unroll
                for (int j = 0; j < 4; ++j) { const size_t kr_ = rowb + (size_t)r * (kt0 + lrow + 8 * j) + rho;
                    gk[j] = *(const u32x4*)(PR + kr_ * 3072 + 1024 + h * 64 + lch * 8); gv[j] = *(const u32x4*)(PR + kr_ * 3072 + 2048 + h * 64 + lch * 8); } }
            f32x16 p0 = {}, p1 = {};
#pragma unroll
            for (int s4 = 0; s4 < 4; ++s4) { const bf16x8 a0 = *(const LAS bf16x8*)(kl + r32 * 144 + s4 * 32 + hi * 16); p0 = MFMA32(a0, qf[s4], p0); }
            { const int base = 160 - 32 * i + r32 - 4 * hi;
#pragma unroll
              for (int rr = 0; rr < 16; ++rr) p0[rr] += tabh[base - ((rr & 3) + 8 * (rr >> 2))]; }
            softmax_update<false>(p0, p1, m, l, o0, o1);
            const bf16x8 pf0 = pack8(p0, 0), pf1 = pack8(p0, 8);
            o0 = MFMA32(vfrag(vl + vrd), pf0, o0); o0 = MFMA32(vfrag(vl + vrd + 1024), pf1, o0);
            o1 = MFMA32(vfrag(vl + vrd + 2048), pf0, o1); o1 = MFMA32(vfrag(vl + vrd + 2048 + 1024), pf1, o1);
        }
        const float lt = l + __shfl_xor(l, 32);
        if (g < 2) {
#pragma unroll
            for (int rr = 0; rr < 16; ++rr) { const int d = crow(rr, hi); *(LAS float*)(wl + (r32 * 68 + d) * 4) = o0[rr]; *(LAS float*)(wl + (r32 * 68 + 32 + d) * 4) = o1[rr]; }
#pragma unroll
            for (int j = 0; j < 8; ++j) { const int q = (lane >> 4) + 4 * j, c4 = lane & 15; const size_t tr = rowb + (size_t)r * (m0 + q) + rho;
                *(f32x4*)(SO + tr * 1024 + h * 64 + c4 * 4) = *(const LAS f32x4*)(wl + (q * 68 + c4 * 4) * 4); }
            if (hi == 0) { SM[qrow * 16 + h] = m; SL[qrow * 16 + h] = lt; }
        } else {
            const float rl = 1.0f / lt;
#pragma unroll
            for (int rr = 0; rr < 16; ++rr) { const int d = crow(rr, hi);
                *(LAS bf16_t*)(wl + r32 * 144 + d * 2) = (bf16_t)f2bf(o0[rr] * rl); *(LAS bf16_t*)(wl + r32 * 144 + (32 + d) * 2) = (bf16_t)f2bf(o1[rr] * rl); }
#pragma unroll
            for (int j = 0; j < 4; ++j) { const int q = lrow + 8 * j; const size_t tr = rowb + (size_t)r * (m0 + q) + rho;
                *(u32x4*)(O + tr * 1024 + h * 64 + lch * 8) = *(const LAS u32x4*)(wl + q * 144 + lch * 16); }
        }
    }
    __syncthreads();
}

#define XB_TMO      128
#define XB_XCNT(j)  (256  + 64 * (j))
#define XB_XSUB(j)  (1280 + 64 * (j))
#define XB_XGEN(j)  (2304 + 64 * (j))
#define XB_TOP      3328
#define XB_TOPGEN   3392
#define XCD_BAR_WORDS 3456
#define XB_SPIN_CAP (1u << 18)
__device__ __forceinline__ unsigned xb_ld(unsigned* p)              { return __hip_atomic_load(p, __ATOMIC_RELAXED, __HIP_MEMORY_SCOPE_AGENT); }
__device__ __forceinline__ unsigned xb_add(unsigned* p, unsigned v) { return __hip_atomic_fetch_add(p, v, __ATOMIC_RELAXED, __HIP_MEMORY_SCOPE_AGENT); }
__device__ __forceinline__ unsigned xb_xcc_id() { return (unsigned)__builtin_amdgcn_s_getreg((3 << 11) | 20) & 0xFu; }
#define XB_SPIN(cond, bar) do { unsigned _sp = 0; while (cond) { __builtin_amdgcn_s_sleep(1); \
    if ((++_sp & 255u) == 0u) { if (xb_ld(&(bar)[XB_TMO])) break; if (_sp > XB_SPIN_CAP) { atomicAdd(&(bar)[XB_TMO], 1u); break; } } } } while (0)
struct XcdBarrier { unsigned* bar; unsigned x; volatile LAS unsigned* st; };
__device__ __forceinline__ XcdBarrier xcd_barrier_post(unsigned* bar, volatile LAS unsigned* st) {
    XcdBarrier b; b.bar = bar; b.x = xb_xcc_id(); b.st = st;
    if (threadIdx.x == 0) (void)xb_add(&bar[XB_XCNT(b.x)], 1u);
    return b;
}
__device__ __forceinline__ void xcd_barrier_complete(unsigned* bar, unsigned x, unsigned& nloc, unsigned& nx) {
    const unsigned G = gridDim.x * gridDim.y * gridDim.z;
    unsigned sum, cnt, mine, sp = 0u;
    for (;;) {
        sum = 0u; cnt = 0u; mine = 0u;
#pragma unroll
        for (unsigned j = 0; j < 16; ++j) { const unsigned c = xb_ld(&bar[XB_XCNT(j)]); sum += c; cnt += (c > 0u) ? 1u : 0u; mine = (j == x) ? c : mine; }
        if (sum == G) break;
        __builtin_amdgcn_s_sleep(1);
        if ((++sp & 255u) == 0u) { if (xb_ld(&bar[XB_TMO])) break; if (sp > XB_SPIN_CAP) { atomicAdd(&bar[XB_TMO], 1u); break; } }
    }
    nloc = mine > 0u ? mine : 1u; nx = cnt > 0u ? cnt : 1u;
}
__device__ __forceinline__ void xcd_barrier(const XcdBarrier& b) {
    asm volatile("s_waitcnt vmcnt(0)" ::: "memory");
    __syncthreads();
    if (threadIdx.x == 0) {
        unsigned* bar = b.bar;
        __builtin_amdgcn_s_waitcnt(0);
        unsigned nloc = b.st[0], nx = b.st[1];
        if (nloc == 0u) { xcd_barrier_complete(bar, b.x, nloc, nx); b.st[0] = nloc; b.st[1] = nx; }
        const unsigned old = xb_add(&bar[XB_XSUB(b.x)], 1u);
        const unsigned gen = old / nloc;
        if (old + 1u == (gen + 1u) * nloc) {
            __builtin_amdgcn_fence(__ATOMIC_RELEASE, "agent");
            asm volatile("s_waitcnt vmcnt(0)" ::: "memory");
            const unsigned og = xb_add(&bar[XB_TOP], 1u);
            const unsigned tg = og / nx;
            if (og + 1u == (tg + 1u) * nx) xb_add(&bar[XB_TOPGEN], 1u);
            else XB_SPIN(xb_ld(&bar[XB_TOPGEN]) == tg, bar);
            __builtin_amdgcn_fence(__ATOMIC_ACQUIRE, "agent");
            xb_add(&bar[XB_XGEN(b.x)], 1u);
            asm volatile("s_waitcnt vmcnt(0)" ::: "memory");
        } else {
            XB_SPIN(xb_ld(&bar[XB_XGEN(b.x)]) == gen, bar);
            __builtin_amdgcn_fence(__ATOMIC_ACQUIRE, "agent");
            asm volatile("s_waitcnt vmcnt(0)" ::: "memory");
        }
    }
    __syncthreads();
}

enum { T_PRO = 0, T_NORM, T_GU, T_F32, T_MLAROW, T_QKVUP, T_MLAATT, T_DILPROJ, T_DILATT };
constexpr int N_PHASES = 28;
__device__ __forceinline__ void phase_desc(int p, int& type, int& a) {
    switch (p) {
        case 0: type = T_PRO; a = 0; break;
        case 1: type = T_NORM; a = 0; break;
        case 2: type = T_GU; a = 0; break;   case 3: type = T_F32; a = 0; break;   case 4: type = T_NORM; a = 1; break;
        case 5: type = T_F32; a = 4; break;  case 6: type = T_MLAROW; a = 0; break; case 7: type = T_QKVUP; a = 0; break; case 8: type = T_MLAATT; a = 0; break;
        case 9: type = T_F32; a = 5; break;  case 10: type = T_NORM; a = 2; break;
        case 11: type = T_GU; a = 1; break;  case 12: type = T_F32; a = 1; break;  case 13: type = T_NORM; a = 3; break;
        case 14: type = T_GU; a = 2; break;  case 15: type = T_F32; a = 2; break;  case 16: type = T_NORM; a = 4; break;
        case 17: type = T_DILPROJ; a = 0; break; case 18: type = T_DILATT; a = 0; break;
        case 19: type = T_DILPROJ; a = 1; break; case 20: type = T_DILATT; a = 1; break;
        case 21: type = T_DILPROJ; a = 2; break; case 22: type = T_DILATT; a = 2; break;
        case 23: type = T_F32; a = 6; break; case 24: type = T_NORM; a = 5; break;
        case 25: type = T_GU; a = 3; break;  case 26: type = T_F32; a = 3; break;
        default: type = T_NORM; a = 6; break;
    }
}

__global__ void __launch_bounds__(512, 2) mk_fwd(Params P0) {
    extern __shared__ __attribute__((aligned(16))) unsigned char lds_raw[];
    LAS unsigned char* lds = (LAS unsigned char*)lds_raw;
    volatile LAS unsigned* MISC = (volatile LAS unsigned*)(lds + RING_BYTES + 320);
    if (threadIdx.x < 32) MISC[threadIdx.x] = 0u;
    __syncthreads();
    XcdBarrier xbar; xbar.bar = (unsigned*)(P0.ws + WS_CTL) + CW_BAR; xbar.x = 0; xbar.st = nullptr;
    if (P0.ph_hi - P0.ph_lo > 1) xbar = xcd_barrier_post((unsigned*)(P0.ws + WS_CTL) + CW_BAR, MISC + 8);
#ifdef MK_DUP_MASK
    for (int pp_ = 2 * P0.ph_lo; pp_ < 2 * P0.ph_hi; ++pp_) {
        const int p = pp_ >> 1;
        int type, a; phase_desc(p, type, a);
        if ((pp_ & 1) && !((((MK_DUP_MASK) >> type) & 1) && (type != T_NORM || a == 0) && (type != T_DILATT || a == 0))) continue;
#else
    for (int p = P0.ph_lo; p < P0.ph_hi; ++p) {
        int type, a; phase_desc(p, type, a);
#endif
        int tid = threadIdx.x; asm volatile("" : "+v"(tid));
        size_t z_ = 0; asm volatile("" : "+s"(z_));
        int G = gridDim.x, bx = blockIdx.x; asm volatile("" : "+s"(G), "+s"(bx));
        const int vcu = (G % 8 == 0) ? (bx % 8) * (G / 8) + bx / 8 : bx;
        Params P;
#pragma unroll
        for (int i = 0; i < 18; ++i) P.in[i] = P0.in[i] + z_;
        P.out = P0.out + z_; P.ws = P0.ws + z_; P.ph_lo = 0; P.ph_hi = 0;
        unsigned char* ws = P.ws;
        bf16_t* WT = (bf16_t*)(ws + WS_WT);
#ifdef MK_ONLY
        if (type != MK_ONLY) continue;
#endif
        switch (type) {
            case T_PRO: p0_prologue(tid, P, lds, vcu, G); break;
            case T_NORM: norm_phase(tid, P, a, vcu, G); break;
            case T_GU: {
                pg8::Gemm g{(const bf16_t*)(ws + WS_HN), WT + (size_t)a * W_FFN_SZ + W_GU0, M, 2 * FF, D};
                pg8::StaticOrder S; S.init(M, 2 * FF, G, bx);
                pg8::EpiSwiGLU E{(bf16_t*)(ws + WS_ACT), FF};
                pg8::gemm_phase<pg8::EpiSwiGLU, pg8::StaticOrder, true, true>(tid, lds, g, S, E);
            } break;
            case T_F32: {
                pg8::Gemm g; pg8::EpiF32 E;
                if (a < 4) { g = pg8::Gemm{(const bf16_t*)(ws + WS_ACT), WT + (size_t)a * W_FFN_SZ + W_DN0, M, D, FF}; E = pg8::EpiF32{(float*)(ws + WS_Y), D}; }
                else if (a == 4) { g = pg8::Gemm{(const bf16_t*)(ws + WS_HN), WT + W_MLAIN, M, 768, D}; E = pg8::EpiF32{(float*)(ws + WS_LAT), 768}; }
                else if (a == 5) { g = pg8::Gemm{(const bf16_t*)(ws + WS_HN), WT + W_MLAO, M, D, D}; E = pg8::EpiF32{(float*)(ws + WS_Y), D}; }
                else { g = pg8::Gemm{(const bf16_t*)(ws + WS_HN), WT + W_DILO, M, D, D}; E = pg8::EpiF32{(float*)(ws + WS_Y), D}; }
                pg8::StaticOrder S; S.init(M, g.N, G, bx);
                pg8::gemm_phase<pg8::EpiF32, pg8::StaticOrder, true, true>(tid, lds, g, S, E);
            } break;
            case T_MLAROW: mla_row_phase(tid, P, vcu, G); break;
            case T_QKVUP: {
#ifndef MK_NOQ
                { pg8::Gemm g{(const bf16_t*)(ws + WS_CQN), WT + W_QUP, M, 1536, 384};
                  pg8::StaticOrder S; S.init(M, 1536, G, bx);
                  pg8::EpiQ E{(bf16_t*)(ws + WS_Q), (const float*)(ws + WS_COS), (const float*)(ws + WS_SIN), C2_MLA};
                  pg8::gemm_phase<pg8::EpiQ, pg8::StaticOrder, true, true>(tid, lds, g, S, E); }
#endif
#ifndef MK_NOKV
                { pg8::Gemm g{(const bf16_t*)(ws + WS_CKVN), WT + W_KVUP, M, 2048, 256};
                  pg8::StaticOrder S; S.init(M, 2048, G, bx);
                  pg8::EpiBf16 E{(bf16_t*)(ws + WS_KN), D, 1024, (size_t)(WS_V - WS_KN) / 2, 1.0f};
                  pg8::gemm_phase<pg8::EpiBf16, pg8::StaticOrder, true, true>(tid, lds, g, S, E); }
#endif
            } break;
            case T_MLAATT: mla_attn_phase(tid, P, lds, vcu); break;
            case T_DILPROJ: {
                pg8::Gemm g{(const bf16_t*)(ws + WS_HN), WT + W_DILIN + (size_t)a * 3072 * 1024, M, 3072, D};
                pg8::StaticOrder S; S.init(M, 3072, G, bx);
                pg8::EpiBf16 E{(bf16_t*)(ws + WS_PROJ), 3072, 1024, (size_t)1024, C2_DIL};
                pg8::gemm_phase<pg8::EpiBf16, pg8::StaticOrder, true, true>(tid, lds, g, S, E);
            } break;
            case T_DILATT: dil_attn_phase(tid, P, lds, a, vcu, G); break;
        }
#ifdef MK_DUP_MASK
        if (pp_ + 1 < 2 * P0.ph_hi) cg::this_grid().sync();
#else
        if (p + 1 < P0.ph_hi) { if (p == P0.ph_lo) cg::this_grid().sync(); else xcd_barrier(xbar); }
#endif
    }
}

extern "C" void kernel_launch(void* const* d_in, const int* in_sizes, int n_in, void* d_out, int out_size, void* d_ws, size_t ws_size, hipStream_t stream) {
    static int grid = 0;
    if (grid == 0) {
        if (n_in != 18 || in_sizes[0] != M * D || out_size != M * D || ws_size < WS_END) { fprintf(stderr, "kernel_launch: unexpected shapes (n_in %d, in0 %d, out %d, ws %zu)\n", n_in, n_in > 0 ? in_sizes[0] : -1, out_size, ws_size); grid = -1; return; }
        int dev = 0, cus = 0, per_cu = 0;
        if (hipGetDevice(&dev) != hipSuccess || hipDeviceGetAttribute(&cus, hipDeviceAttributeMultiprocessorCount, dev) != hipSuccess) { grid = -1; return; }
        if (hipFuncSetAttribute((const void*)mk_fwd, hipFuncAttributeMaxDynamicSharedMemorySize, LDS_BYTES) != hipSuccess) { fprintf(stderr, "kernel_launch: hipFuncSetAttribute failed\n"); grid = -1; return; }
        if (hipOccupancyMaxActiveBlocksPerMultiprocessor(&per_cu, (const void*)mk_fwd, 512, LDS_BYTES) != hipSuccess || per_cu < 1) { fprintf(stderr, "kernel_launch: occupancy query says %d\n", per_cu); (void)hipGetLastError(); per_cu = 1; }
        grid = cus;
        fprintf(stderr, "kernel_launch: cus %d per_cu %d grid %d ws %zu\n", cus, per_cu, grid, ws_size);
    }
    if (grid < 0) return;
    if (hipMemsetAsync((char*)d_ws + WS_CTL, 0, CTL_ZERO_BYTES, stream) != hipSuccess) { fprintf(stderr, "kernel_launch: memset failed\n"); return; }
    Params p{};
    for (int i = 0; i < 18; ++i) p.in[i] = (const float*)d_in[i];
    p.out = (float*)d_out; p.ws = (unsigned char*)d_ws;
#if MK_ONE_LAUNCH
    p.ph_lo = 0; p.ph_hi = N_PHASES;
    { void* args[] = {&p}; hipError_t e = hipLaunchCooperativeKernel((const void*)mk_fwd, dim3(grid), dim3(512), args, LDS_BYTES, stream);
      if (e != hipSuccess) fprintf(stderr, "cooperative launch failed: %s\n", hipGetErrorString(e)); }
#else
    for (int ph = 0; ph < N_PHASES; ++ph) {
        p.ph_lo = ph; p.ph_hi = ph + 1;
        void* args[] = {&p}; hipError_t e = hipLaunchCooperativeKernel((const void*)mk_fwd, dim3(grid), dim3(512), args, LDS_BYTES, stream);
        if (e != hipSuccess) { fprintf(stderr, "cooperative launch %d failed: %s\n", ph, hipGetErrorString(e)); break; }
    }
#endif
}
```
